# Optimizing an MI355X kernel written in HIP

```python
import jax, jax.numpy as jnp
from jax import lax
import numpy as np

D_MODEL = 2048
BATCH = 4
SEQ = 8192
DEPTH = 4
DEC_BATCH = 1
DEC_SEQ = 16384
PAST_LEN = 128

CONV_DIM = 512
CONV_WIDTH = 3
NA_HEADS = 12
NA_HEAD_DIM = 64
NA_DIM = NA_HEADS * NA_HEAD_DIM
GRID_W = 64
WIN_R_MAX = 8
WIN_C = 16
Q_COL_BLK = 16
K_COL_BLK = 32
N_COL_BLK = GRID_W // Q_COL_BLK
HG_HEADS = 6
HG_DK = 128
HG_DV = 128
HG_DIM = HG_HEADS * HG_DK
HG_CHUNK = 64
F_MIN = 1e-30
D_FF = ((8 * D_MODEL + 3 * 256 - 1) // (3 * 256)) * 256
EPS = 1e-6
NEG_INF = -1e30
SPLIT_WIDTHS = (CONV_DIM,) * 3 + (NA_DIM,) * 3 + (HG_DIM,) * 5 + (D_MODEL,) * 3
D_IN = sum(SPLIT_WIDTHS)

kernel_name = 'hybrid_conv_natten_hgrn2_encoder'


def _split_points():
    return [int(v) for v in np.cumsum(SPLIT_WIDTHS)[:-1]]


def _rmsnorm(x, g):
    xf = x.astype(jnp.float32)
    y = xf * lax.rsqrt(jnp.mean(xf * xf, axis=-1, keepdims=True) + EPS)
    return (y * g.astype(jnp.float32)).astype(x.dtype)


def _short_conv_mixer(h, gate_b, gate_c, w):
    u = gate_c * h
    up = jnp.pad(u, ((0, 0), (1, 1), (0, 0)))
    y = up[:, :-2] * w[0] + up[:, 1:-1] * w[1] + up[:, 2:] * w[2]
    return gate_b * y


def _col_tables():
    c = np.arange(GRID_W).reshape(N_COL_BLK, Q_COL_BLK)
    k_start = np.clip(np.arange(N_COL_BLK) * Q_COL_BLK - (K_COL_BLK - Q_COL_BLK) // 2, 0, GRID_W - K_COL_BLK)
    col_ids = k_start[:, None] + np.arange(K_COL_BLK)
    cs = np.clip(c - WIN_C // 2, 0, GRID_W - WIN_C)
    kc = col_ids[:, None, :]
    mask = (kc >= cs[:, :, None]) & (kc < cs[:, :, None] + WIN_C)
    dc = np.clip(kc - c[:, :, None] + WIN_C - 1, 0, 2 * WIN_C - 2)
    return col_ids, mask, dc


def _neighbourhood_attention(q, k, v, rpb):
    B, L, _ = q.shape
    rows = L // GRID_W
    wr = min(WIN_R_MAX, rows)
    grid = lambda t: t.reshape(B, rows, GRID_W, NA_HEADS, NA_HEAD_DIM)
    qg, kg, vg = grid(q), grid(k), grid(v)
    col_ids, mask, dc = _col_tables()
    col_ids = jnp.asarray(col_ids)
    mask = jnp.asarray(mask)[:, None, :, None, :]
    dc = jnp.asarray(dc)
    scale = NA_HEAD_DIM ** -0.5

    def one_row(r):
        rs = jnp.clip(r - wr // 2, 0, rows - wr)

        def gather_block(t):
            t = lax.dynamic_slice_in_dim(t, rs, wr, axis=1)[:, :, col_ids]
            return t.transpose(0, 2, 1, 3, 4, 5).reshape(B, N_COL_BLK, wr * K_COL_BLK, NA_HEADS, NA_HEAD_DIM)

        kb, vb = gather_block(kg), gather_block(vg)
        qr = lax.dynamic_index_in_dim(qg, r, axis=1, keepdims=False)
        qr = qr.reshape(B, N_COL_BLK, Q_COL_BLK, NA_HEADS, NA_HEAD_DIM)
        dr = rs + jnp.arange(wr) - r + WIN_R_MAX - 1
        bias = rpb[:, dr][:, :, dc]
        bias = jnp.where(mask, bias.transpose(2, 0, 3, 1, 4).astype(jnp.float32), NEG_INF)
        bias = bias.reshape(N_COL_BLK, NA_HEADS, Q_COL_BLK, wr * K_COL_BLK)
        s = jnp.einsum('bjqhd,bjkhd->bjhqk', qr, kb).astype(jnp.float32) * scale + bias
        p = jax.nn.softmax(s, axis=-1).astype(v.dtype)
        o = jnp.einsum('bjhqk,bjkhd->bjqhd', p, vb)
        return o.reshape(B, GRID_W, NA_DIM)

    out = lax.map(one_row, jnp.arange(rows))
    return out.transpose(1, 0, 2, 3).reshape(B, L, NA_DIM)


def _gla_chunk_scan(q, k, v, g):
    B, L, H, dk = q.shape
    dv = v.shape[-1]
    n = L // HG_CHUNK
    to_chunks = lambda t: t.reshape(B, n, HG_CHUNK, H, t.shape[-1]).transpose(1, 0, 3, 2, 4)
    tri = jnp.tril(jnp.ones((HG_CHUNK, HG_CHUNK), dtype=bool))

    def step(S, inp):
        qc, kc, vc, gc = inp
        b = jnp.cumsum(gc, axis=2)
        inter = jnp.einsum('bhsc,bhcv->bhsv', qc * jnp.exp(b), S)
        diff = b[:, :, :, None, :] - b[:, :, None, :, :]
        decay = jnp.where(tri[:, :, None], jnp.exp(jnp.minimum(diff, 0.0)), 0.0)
        A = jnp.einsum('bhsc,bhuc,bhsuc->bhsu', qc, kc, decay)
        intra = jnp.einsum('bhsu,bhuv->bhsv', A, vc)
        b_last = b[:, :, -1:, :]
        S = jnp.exp(b_last[:, :, 0, :, None]) * S + jnp.einsum('bhuc,bhuv->bhcv', kc * jnp.exp(b_last - b), vc)
        return S, inter + intra

    S0 = jnp.zeros((B, H, dk, dv), jnp.float32)
    _, o = lax.scan(step, S0, (to_chunks(q), to_chunks(k), to_chunks(v), to_chunks(g)))
    return o.transpose(1, 0, 3, 2, 4).reshape(B, L, H, dv)


def _hgrn2_mixer(cq, cf_fwd, cf_bwd, ci, cg, lb, norm_g):
    B, L, _ = cq.shape
    heads = lambda t: t.astype(jnp.float32).reshape(B, L, HG_HEADS, -1)
    q = jax.nn.silu(heads(cq))
    v = heads(ci)

    def run(zf, lb_d, rev):
        lb_h = lb_d.reshape(HG_HEADS, HG_DK)
        f = lb_h + (1.0 - lb_h) * jax.nn.sigmoid(heads(zf))
        logf = jnp.log(jnp.maximum(f, F_MIN))
        k = 1.0 - f
        args = (q, k, v, logf)
        if rev:
            args = tuple(jnp.flip(t, axis=1) for t in args)
        o = _gla_chunk_scan(*args)
        return jnp.flip(o, axis=1) if rev else o

    o = run(cf_fwd, lb[0], False) + run(cf_bwd, lb[1], True)
    o = o * lax.rsqrt(jnp.mean(o * o, axis=-1, keepdims=True) + EPS)
    o = o.reshape(B, L, HG_DIM) * norm_g.astype(jnp.float32)
    return (o * jax.nn.silu(cg.astype(jnp.float32))).astype(cq.dtype)


def _trunk(x, norm1_g, w_in, conv_w, rpb, lb_all, hg_norm_g, w_br_conv, w_br_attn, w_br_hgrn,
           w_mix_out, norm2_g, w_ffn_gate, w_ffn_up, w_ffn_down, final_g):
    for l in range(DEPTH):
        h = _rmsnorm(x, norm1_g[l])
        p = jnp.einsum('bld,de->ble', h, w_in[l])
        (a_h, a_b, a_c, nq, nk, nv, cq, cff, cfb, ci, cg, ga, gb, gc) = jnp.split(p, _split_points(), axis=-1)
        y_a = _short_conv_mixer(a_h, a_b, a_c, conv_w[l])
        y_b = _neighbourhood_attention(nq, nk, nv, rpb[l])
        y_c = _hgrn2_mixer(cq, cff, cfb, ci, cg, lb_all[l], hg_norm_g[l])
        mix = (jax.nn.sigmoid(ga) * (y_a @ w_br_conv[l])
               + jax.nn.sigmoid(gb) * (y_b @ w_br_attn[l])
               + jax.nn.sigmoid(gc) * (y_c @ w_br_hgrn[l]))
        x = x + mix @ w_mix_out[l]
        h = _rmsnorm(x, norm2_g[l])
        x = x + (jax.nn.silu(h @ w_ffn_gate[l]) * (h @ w_ffn_up[l])) @ w_ffn_down[l]
    return _rmsnorm(x, final_g)


def setup_inputs(seed: int = 0) -> dict:
    key = jax.random.key(seed)
    ks = jax.random.split(key, 20)
    nrm = lambda k, shape, s: jax.random.normal(k, shape, jnp.float32) * s
    return {
        'x_prompt': nrm(ks[0], (BATCH, SEQ, D_MODEL), 1.0),
        'x_sample': nrm(ks[1], (DEC_BATCH, DEC_SEQ, D_MODEL), 1.0),
        'norm1_g': 1.0 + nrm(ks[2], (DEPTH, D_MODEL), 0.02),
        'w_in': nrm(ks[3], (DEPTH, D_MODEL, D_IN), D_MODEL ** -0.5),
        'conv_w': nrm(ks[4], (DEPTH, CONV_WIDTH, CONV_DIM), CONV_WIDTH ** -0.5),
        'rpb': nrm(ks[5], (DEPTH, NA_HEADS, 2 * WIN_R_MAX - 1, 2 * WIN_C - 1), 0.5),
        'hg_lower': nrm(ks[6], (DEPTH, 2, HG_DIM), 0.5),
        'hg_norm_g': 1.0 + nrm(ks[7], (DEPTH, HG_DIM), 0.02),
        'w_br_conv': nrm(ks[8], (DEPTH, CONV_DIM, D_MODEL), CONV_DIM ** -0.5),
        'w_br_attn': nrm(ks[9], (DEPTH, NA_DIM, D_MODEL), NA_DIM ** -0.5),
        'w_br_hgrn': nrm(ks[10], (DEPTH, HG_DIM, D_MODEL), HG_DIM ** -0.5),
        'w_mix_out': nrm(ks[11], (DEPTH, D_MODEL, D_MODEL), D_MODEL ** -0.5),
        'norm2_g': 1.0 + nrm(ks[12], (DEPTH, D_MODEL), 0.02),
        'w_ffn_gate': nrm(ks[13], (DEPTH, D_MODEL, D_FF), D_MODEL ** -0.5),
        'w_ffn_up': nrm(ks[14], (DEPTH, D_MODEL, D_FF), D_MODEL ** -0.5),
        'w_ffn_down': nrm(ks[15], (DEPTH, D_FF, D_MODEL), D_FF ** -0.5),
        'final_g': 1.0 + nrm(ks[16], (D_MODEL,), 0.02),
    }


def reference(x_prompt, x_sample, norm1_g, w_in, conv_w, rpb, hg_lower, hg_norm_g, w_br_conv, w_br_attn,
              w_br_hgrn, w_mix_out, norm2_g, w_ffn_gate, w_ffn_up, w_ffn_down, final_g):
    sm = jax.nn.softmax(hg_lower.astype(jnp.float32), axis=0)
    lb_all = jnp.cumsum(sm, axis=0) - sm[0]
    y_prompt = _trunk(x_prompt, norm1_g, w_in, conv_w, rpb, lb_all, hg_norm_g, w_br_conv, w_br_attn,
                      w_br_hgrn, w_mix_out, norm2_g, w_ffn_gate, w_ffn_up, w_ffn_down, final_g)
    y_sample = _trunk(x_sample, norm1_g, w_in, conv_w, rpb, lb_all, hg_norm_g, w_br_conv, w_br_attn,
                      w_br_hgrn, w_mix_out, norm2_g, w_ffn_gate, w_ffn_up, w_ffn_down, final_g)
    return (y_prompt, y_sample)
```

```cpp
#ifndef ACT_GATE
#define ACT_GATE 1
#endif
#ifndef ACT_CG
#define ACT_CG 1
#endif
#ifndef ACT_HG
#define ACT_HG 1
#endif
#ifndef ACT_Q8
#define ACT_Q8 1
#endif
#include <hip/hip_runtime.h>
#include <cstdio>
#include <cstdint>

namespace pg8 {
#define PG8_LAS __attribute__((address_space(3)))
typedef unsigned short bf16_t;
typedef short bf16x8 __attribute__((ext_vector_type(8)));
typedef float f32x4 __attribute__((ext_vector_type(4)));
typedef unsigned u32x4 __attribute__((ext_vector_type(4)));
constexpr int BM = 256, BK = 64, HALF = 128, HTB = HALF * BK * 2  , STAGE_BYTES = 8 * HTB, NXCD = 8, WGM = 8;

__host__ __device__ __forceinline__ int lds_byte(int r, int c) { const int st = (r >> 4) * 2 + (c >> 5), rr = r & 15, cc = c & 31, ob = rr * 64 + cc * 2; return st * 1024 + (ob ^ (((ob >> 9) & 1) << 5)); }
__host__ __device__ __forceinline__ void stage_rc(int b, int& R, int& C) { const int st = b / 1024, sb = b % 1024, swz = sb ^ (((sb >> 9) & 1) << 5); R = (st >> 1) * 16 + swz / 64; C = (st & 1) * 32 + (swz % 64) / 2; }
__host__ __device__ __forceinline__ int perm32(int rho) { const int n = rho >> 4, i = rho & 15; return 8 * (i >> 2) + 4 * n + (i & 3); }

struct Unit { int pm, pn; };
struct Gemm { const bf16_t* A; const bf16_t* Bt; int M, N, K, lda, ldb; };

struct StaticOrder {
    int nM, nN, nwg, G, c;
    __host__ __device__ __forceinline__ void init(int M, int N, int G_, int c_) { nM = M / BM; nN = N / BM; nwg = nM * nN; G = G_; c = c_; }
    __host__ __device__ __forceinline__ bool next(int i, Unit& u) const {
        const long L = (long)i * G + c; if (L >= nwg) return false;
        int wgid = (int)L; { const int q = nwg / NXCD, r = nwg % NXCD, xcd = wgid % NXCD, off = wgid / NXCD; wgid = (xcd < r ? xcd * (q + 1) : r * (q + 1) + (xcd - r) * q) + off; }
        const int nig = WGM * nN, gid = wgid / nig, fm = gid * WGM, gsz = (nM - fm) < WGM ? (nM - fm) : WGM;
        u.pm = fm + ((wgid % nig) % gsz); u.pn = (wgid % nig) / gsz; return true;
    }
    __device__ __forceinline__ void a_ready(const Unit&) const {}
    __device__ __forceinline__ void done(const Unit&) const {}
};

typedef float cvt_f32x2 __attribute__((ext_vector_type(2))); typedef __bf16 cvt_bf16x2 __attribute__((ext_vector_type(2)));
__device__ __forceinline__ unsigned cvt_pk_bf16(float lo, float hi) { const cvt_f32x2 v = {lo, hi}; const cvt_bf16x2 b = __builtin_convertvector(v, cvt_bf16x2); return __builtin_bit_cast(unsigned, b); }
__device__ __forceinline__ float bflo(unsigned w) { return __uint_as_float(w << 16); }
__device__ __forceinline__ float bfhi(unsigned w) { return __uint_as_float(w & 0xffff0000u); }
__device__ __forceinline__ float sigmoidf_(float x) { return __builtin_amdgcn_rcpf(1.0f + __expf(-x)); }
__device__ __forceinline__ float siluf_(float x) { return x * __builtin_amdgcn_rcpf(1.0f + __expf(-x)); }
__device__ __forceinline__ f32x4 rsig2_(f32x4 t) { f32x4 d = (f32x4){__builtin_amdgcn_exp2f(t[0]), __builtin_amdgcn_exp2f(t[1]), __builtin_amdgcn_exp2f(t[2]), __builtin_amdgcn_exp2f(t[3])} + 1.0f;
    return (f32x4){__builtin_amdgcn_rcpf(d[0]), __builtin_amdgcn_rcpf(d[1]), __builtin_amdgcn_rcpf(d[2]), __builtin_amdgcn_rcpf(d[3])}; }

template <bool SCALE, bool ACTS> struct EpiP {
    static constexpr bool PERM = true, AFTER_DRAIN = false, IDEMPOTENT = true; static constexpr bool HOOKS = false; static constexpr int HOOK_T0 = -1, HOOK_T1 = -1;
    bf16_t* O; int ldc; const PG8_LAS float* rsl; const float* lbc;
    template <int MODE> __device__ __forceinline__ void rows(const f32x4 (&acc)[2][2][4][2], const Unit& u, int wr, int wc, int fr, int fq) const {
        const int rl0 = wr * 64 + fr, row0 = u.pm * BM + rl0, col0 = u.pn * BM + wc * 32 + 8 * fq;
        f32x4 om[2][2];
        if (MODE == 3) {
#pragma unroll
            for (int bj = 0; bj < 2; ++bj)
#pragma unroll
                for (int n = 0; n < 2; ++n) om[bj][n] = 1.0f - *(const f32x4*)(lbc + col0 + bj * HALF + 4 * n);
        }
#pragma unroll
        for (int ai = 0; ai < 2; ++ai)
#pragma unroll
            for (int m = 0; m < 4; ++m) { bf16_t* rowp = O + (size_t)(row0 + ai * HALF + m * 16) * ldc + col0;
                float rs = 1.0f; if (SCALE) rs = rsl[rl0 + ai * HALF + m * 16];
#pragma unroll
                for (int bj = 0; bj < 2; ++bj) { f32x4 v[2] = {acc[ai][bj][m][0], acc[ai][bj][m][1]};
#pragma unroll
                    for (int n = 0; n < 2; ++n) { if (SCALE) v[n] = v[n] * rs;
#pragma unroll
                        for (int e = 0; e < 4; ++e) { const float x = v[n][e];
                            if (MODE == 1) v[n][e] = x * sigmoidf_(x);
                            if (MODE == 2) v[n][e] = sigmoidf_(x);
                            if (MODE == 3) v[n][e] = om[bj][n][e] * sigmoidf_(-x);
                            if (MODE == 4) v[n][e] = x * (0.125f * 1.4426950408889634f);     } }
                    u32x4 w; w.x = cvt_pk_bf16(v[0][0], v[0][1]); w.y = cvt_pk_bf16(v[0][2], v[0][3]); w.z = cvt_pk_bf16(v[1][0], v[1][1]); w.w = cvt_pk_bf16(v[1][2], v[1][3]);
                    *(u32x4*)(rowp + bj * HALF) = w; } }
    }
    __device__ __forceinline__ void operator()(const f32x4 (&acc)[2][2][4][2], const Unit& u, int wr, int wc, int fr, int fq) const {
        if (!ACTS) { rows<0>(acc, u, wr, wc, fr, fq); return; }
        const int pn = u.pn;
        if (ACT_GATE && pn >= 27) rows<2>(acc, u, wr, wc, fr, fq);
        else if ((ACT_CG && pn >= 24 && pn < 27) || (ACT_HG && pn >= 12 && pn < 15)) rows<1>(acc, u, wr, wc, fr, fq);
        else if (ACT_HG && pn >= 15 && pn < 21) rows<3>(acc, u, wr, wc, fr, fq);
        else if (ACT_Q8 && pn >= 6 && pn < 9) rows<4>(acc, u, wr, wc, fr, fq);
        else rows<0>(acc, u, wr, wc, fr, fq);
    }
};
struct EpiVT {
    static constexpr bool PERM = true, AFTER_DRAIN = false, IDEMPOTENT = true; static constexpr bool HOOKS = false; static constexpr int HOOK_T0 = -1, HOOK_T1 = -1;
    bf16_t* O; int ldc; const PG8_LAS float* rsl;
    __device__ __forceinline__ void operator()(const f32x4 (&acc)[2][2][4][2], const Unit& u, int wr, int wc, int fr, int fq) const {
        const int row0 = u.pm * BM + wr * 64 + fr, cl0 = wc * 32 + 8 * fq, col0 = u.pn * BM + cl0;
        f32x4 cs[2][2];
#pragma unroll
        for (int bj = 0; bj < 2; ++bj)
#pragma unroll
            for (int n = 0; n < 2; ++n) cs[bj][n] = *(const PG8_LAS f32x4*)(rsl + cl0 + bj * HALF + 4 * n);
#pragma unroll
        for (int ai = 0; ai < 2; ++ai)
#pragma unroll
            for (int m = 0; m < 4; ++m) { bf16_t* rowp = O + (size_t)(row0 + ai * HALF + m * 16) * ldc + col0;
#pragma unroll
                for (int bj = 0; bj < 2; ++bj) { const f32x4 v0 = acc[ai][bj][m][0] * cs[bj][0], v1 = acc[ai][bj][m][1] * cs[bj][1];
                    u32x4 w; w.x = cvt_pk_bf16(v0[0], v0[1]); w.y = cvt_pk_bf16(v0[2], v0[3]); w.z = cvt_pk_bf16(v1[0], v1[1]); w.w = cvt_pk_bf16(v1[2], v1[3]);
                    *(u32x4*)(rowp + bj * HALF) = w; } }
    }
};
struct OneUnit {
    int pm, pn, have;
    __device__ __forceinline__ bool next(int i, Unit& u) const { if (i != 0 || !have) return false; u.pm = pm; u.pn = pn; return true; }
    __device__ __forceinline__ void a_ready(const Unit&) const {}
    __device__ __forceinline__ void done(const Unit&) const {}
};
#define GSIG(x) (ACT_GATE ? (x) : sigmoidf_(x))
struct EpiGate {
    static constexpr bool PERM = true, AFTER_DRAIN = false, IDEMPOTENT = false; static constexpr bool HOOKS = false; static constexpr int HOOK_T0 = -1, HOOK_T1 = -1;
    const bf16_t* G; int ldg; bf16_t* MIX; int ldm; int first;
    __device__ __forceinline__ void operator()(const f32x4 (&acc)[2][2][4][2], const Unit& u, int wr, int wc, int fr, int fq) const {
        const int row0 = u.pm * BM + wr * 64 + fr, col0 = u.pn * BM + wc * 32 + 8 * fq;
#pragma unroll
        for (int ai = 0; ai < 2; ++ai)
#pragma unroll
            for (int m = 0; m < 4; ++m) { const size_t row = (size_t)(row0 + ai * HALF + m * 16);
#pragma unroll
                for (int bj = 0; bj < 2; ++bj) { const f32x4 v0 = acc[ai][bj][m][0], v1 = acc[ai][bj][m][1];
                    const u32x4 gw = *(const u32x4*)(G + row * ldg + col0 + bj * HALF);
                    bf16_t* mp = MIX + row * ldm + col0 + bj * HALF;
                    u32x4 pw = (u32x4){0u, 0u, 0u, 0u}; if (!first) pw = *(const u32x4*)mp;
                    u32x4 w;
                    w.x = cvt_pk_bf16(bflo(pw.x) + GSIG(bflo(gw.x)) * v0[0], bfhi(pw.x) + GSIG(bfhi(gw.x)) * v0[1]);
                    w.y = cvt_pk_bf16(bflo(pw.y) + GSIG(bflo(gw.y)) * v0[2], bfhi(pw.y) + GSIG(bfhi(gw.y)) * v0[3]);
                    w.z = cvt_pk_bf16(bflo(pw.z) + GSIG(bflo(gw.z)) * v1[0], bfhi(pw.z) + GSIG(bfhi(gw.z)) * v1[1]);
                    w.w = cvt_pk_bf16(bflo(pw.w) + GSIG(bflo(gw.w)) * v1[2], bfhi(pw.w) + GSIG(bfhi(gw.w)) * v1[3]);
                    *(u32x4*)mp = w; } }
    }
};
struct EpiGate3 {
    static constexpr bool PERM = true, AFTER_DRAIN = false, IDEMPOTENT = true, HOOKS = true; static constexpr int HOOK_T0 = 8, HOOK_T1 = 20;
    const bf16_t* G; int ldg; bf16_t* MIX; int ldm;
    __device__ __forceinline__ void hook(f32x4 (&acc)[2][2][4][2], const Unit& u, int wr, int wc, int fr, int fq, int which) const {
        int fr_ = fr, fq_ = fq; asm volatile("" : "+v"(fr_), "+v"(fq_));
        const int row0 = u.pm * BM + wr * 64 + fr_, col0 = u.pn * BM + wc * 32 + 8 * fq_; const bf16_t* gn = G + which * 2048; const bf16_t* gd = gn + 2048;
#pragma unroll
        for (int ai = 0; ai < 2; ++ai)
#pragma unroll
            for (int m = 0; m < 4; ++m) { const size_t off = (size_t)(row0 + ai * HALF + m * 16) * ldg + col0;
#pragma unroll
                for (int bj = 0; bj < 2; ++bj) { const u32x4 nw = *(const u32x4*)(gn + off + bj * HALF), dw = *(const u32x4*)(gd + off + bj * HALF);
#define PG8_RATIO(n_, d_) ((n_) * __builtin_amdgcn_rcpf(fmaxf((d_), 9.5367431640625e-7f)))
                    acc[ai][bj][m][0][0] *= PG8_RATIO(bflo(nw.x), bflo(dw.x)); acc[ai][bj][m][0][1] *= PG8_RATIO(bfhi(nw.x), bfhi(dw.x));
                    acc[ai][bj][m][0][2] *= PG8_RATIO(bflo(nw.y), bflo(dw.y)); acc[ai][bj][m][0][3] *= PG8_RATIO(bfhi(nw.y), bfhi(dw.y));
                    acc[ai][bj][m][1][0] *= PG8_RATIO(bflo(nw.z), bflo(dw.z)); acc[ai][bj][m][1][1] *= PG8_RATIO(bfhi(nw.z), bfhi(dw.z));
                    acc[ai][bj][m][1][2] *= PG8_RATIO(bflo(nw.w), bflo(dw.w)); acc[ai][bj][m][1][3] *= PG8_RATIO(bfhi(nw.w), bfhi(dw.w));
#undef PG8_RATIO
                }
                if (m == 3) asm volatile("" ::: "memory"); }
    }
    __device__ __forceinline__ void operator()(const f32x4 (&acc)[2][2][4][2], const Unit& u, int wr, int wc, int fr, int fq) const {
        const int row0 = u.pm * BM + wr * 64 + fr, col0 = u.pn * BM + wc * 32 + 8 * fq;
#pragma unroll
        for (int ai = 0; ai < 2; ++ai)
#pragma unroll
            for (int m = 0; m < 4; ++m) { const size_t row = (size_t)(row0 + ai * HALF + m * 16);
#pragma unroll
                for (int bj = 0; bj < 2; ++bj) { const f32x4 v0 = acc[ai][bj][m][0], v1 = acc[ai][bj][m][1];
                    const u32x4 gw = *(const u32x4*)(G + 4096 + row * ldg + col0 + bj * HALF);
                    u32x4 w;
                    w.x = cvt_pk_bf16(fmaxf(bflo(gw.x), 9.5367431640625e-7f) * v0[0], fmaxf(bfhi(gw.x), 9.5367431640625e-7f) * v0[1]); w.y = cvt_pk_bf16(fmaxf(bflo(gw.y), 9.5367431640625e-7f) * v0[2], fmaxf(bfhi(gw.y), 9.5367431640625e-7f) * v0[3]);
                    w.z = cvt_pk_bf16(fmaxf(bflo(gw.z), 9.5367431640625e-7f) * v1[0], fmaxf(bfhi(gw.z), 9.5367431640625e-7f) * v1[1]); w.w = cvt_pk_bf16(fmaxf(bflo(gw.w), 9.5367431640625e-7f) * v1[2], fmaxf(bfhi(gw.w), 9.5367431640625e-7f) * v1[3]);
                    *(u32x4*)(MIX + row * ldm + col0 + bj * HALF) = w; } }
    }
};
__device__ __forceinline__ unsigned pack4_u8(float a, float b, float c, float d) {
    unsigned r = 0u; r = __builtin_amdgcn_cvt_pk_u8_f32(a, 0, r); r = __builtin_amdgcn_cvt_pk_u8_f32(b, 1, r); r = __builtin_amdgcn_cvt_pk_u8_f32(c, 2, r); r = __builtin_amdgcn_cvt_pk_u8_f32(d, 3, r); return r; }
__device__ __forceinline__ float ub0(unsigned w) { return (float)(w & 0xffu); }
__device__ __forceinline__ float ub1(unsigned w) { return (float)((w >> 8) & 0xffu); }
__device__ __forceinline__ float ub2(unsigned w) { return (float)((w >> 16) & 0xffu); }
__device__ __forceinline__ float ub3(unsigned w) { return (float)(w >> 24); }
struct EpiP16 {
    static constexpr int PERM = 2; static constexpr bool AFTER_DRAIN = false, IDEMPOTENT = true, HOOKS = false; static constexpr int HOOK_T0 = -1, HOOK_T1 = -1;
    bf16_t* O; int ldc; const PG8_LAS float* rsl; const float* lbc; unsigned char* G8; int ldg8;
    template <int MODE> __device__ __forceinline__ void rows(const f32x4 (&acc)[2][2][4][2], const Unit& u, int wr, int wc, int fr, int fq) const {
        const int rl0 = wr * 64 + fr, row0 = u.pm * BM + rl0, col0 = u.pn * BM + wc * 64 + 16 * fq;
        f32x4 om[2][2];
        if (MODE == 3) {
#pragma unroll
            for (int bj = 0; bj < 2; ++bj)
#pragma unroll
                for (int n = 0; n < 2; ++n) om[bj][n] = 1.0f - *(const f32x4*)(lbc + col0 + 8 * bj + 4 * n);
        }
#pragma unroll
        for (int ai = 0; ai < 2; ++ai)
#pragma unroll
            for (int m = 0; m < 4; ++m) { const int row = row0 + ai * HALF + m * 16; const float rs0 = rsl[rl0 + ai * HALF + m * 16];
                const float rs = (MODE == 1 || MODE == 2) ? rs0 * -1.4426950408889634f : (MODE == 3) ? rs0 * 1.4426950408889634f : (MODE == 4) ? rs0 * (0.125f * 1.4426950408889634f) : rs0;
                f32x4 v[2][2];
#pragma unroll
                for (int bj = 0; bj < 2; ++bj)
#pragma unroll
                    for (int n = 0; n < 2; ++n) { const f32x4 t = acc[ai][bj][m][n] * rs;
                        if (MODE == 0 || MODE == 4) v[bj][n] = t;
                        if (MODE == 1) v[bj][n] = (acc[ai][bj][m][n] * rs0) * rsig2_(t);
                        if (MODE == 3) v[bj][n] = om[bj][n] * rsig2_(t);
                        if (MODE == 2) { const f32x4 d = (f32x4){__builtin_amdgcn_exp2f(t[0]), __builtin_amdgcn_exp2f(t[1]), __builtin_amdgcn_exp2f(t[2]), __builtin_amdgcn_exp2f(t[3])} * (1.0f / 255.0f) + (1.0f / 255.0f);
#pragma unroll
                            for (int e = 0; e < 4; ++e) v[bj][n][e] = fmaxf(__builtin_rintf(__builtin_amdgcn_rcpf(d[e])), 1.0f); } }
                if (MODE == 2) { u32x4 w; w.x = pack4_u8(v[0][0][0], v[0][0][1], v[0][0][2], v[0][0][3]); w.y = pack4_u8(v[0][1][0], v[0][1][1], v[0][1][2], v[0][1][3]);
                    w.z = pack4_u8(v[1][0][0], v[1][0][1], v[1][0][2], v[1][0][3]); w.w = pack4_u8(v[1][1][0], v[1][1][1], v[1][1][2], v[1][1][3]);
                    *(u32x4*)(G8 + (size_t)row * ldg8 + (col0 - 6912)) = w; }
                else { bf16_t* rowp = O + (size_t)row * ldc + col0;
#pragma unroll
                    for (int bj = 0; bj < 2; ++bj) { u32x4 w; w.x = cvt_pk_bf16(v[bj][0][0], v[bj][0][1]); w.y = cvt_pk_bf16(v[bj][0][2], v[bj][0][3]); w.z = cvt_pk_bf16(v[bj][1][0], v[bj][1][1]); w.w = cvt_pk_bf16(v[bj][1][2], v[bj][1][3]);
                        *(u32x4*)(rowp + 8 * bj) = w; } } }
    }
    __device__ __forceinline__ void operator()(const f32x4 (&acc)[2][2][4][2], const Unit& u, int wr, int wc, int fr, int fq) const {
        const int pn = u.pn;
        if (pn >= 27) rows<2>(acc, u, wr, wc, fr, fq);
        else if (pn >= 24 || (pn >= 12 && pn < 15)) rows<1>(acc, u, wr, wc, fr, fq);
        else if (pn >= 15 && pn < 21) rows<3>(acc, u, wr, wc, fr, fq);
        else if (pn >= 6 && pn < 9) rows<4>(acc, u, wr, wc, fr, fq);
        else rows<0>(acc, u, wr, wc, fr, fq);
    }
};
struct EpiGate16 {
    static constexpr int PERM = 2; static constexpr bool AFTER_DRAIN = false, IDEMPOTENT = true, HOOKS = true; static constexpr int HOOK_T0 = 8, HOOK_T1 = 20;
    const unsigned char* G8; int ldg8; bf16_t* MIX; int ldm;
    __device__ __forceinline__ void hook(f32x4 (&acc)[2][2][4][2], const Unit& u, int wr, int wc, int fr, int fq, int which) const {
        int fr_ = fr, fq_ = fq; asm volatile("" : "+v"(fr_), "+v"(fq_));
        const int row0 = u.pm * BM + wr * 64 + fr_, col0 = u.pn * BM + wc * 64 + 16 * fq_; const unsigned char* gn = G8 + which * 2048; const unsigned char* gd = gn + 2048;
#pragma unroll
        for (int ai = 0; ai < 2; ++ai)
#pragma unroll
            for (int m = 0; m < 4; ++m) { const size_t off = (size_t)(row0 + ai * HALF + m * 16) * ldg8 + col0;
                const u32x4 nw = *(const u32x4*)(gn + off), dw = *(const u32x4*)(gd + off);
#define PG8_R8(n_, d_) ((n_) * __builtin_amdgcn_rcpf(d_))
                acc[ai][0][m][0][0] *= PG8_R8(ub0(nw.x), ub0(dw.x)); acc[ai][0][m][0][1] *= PG8_R8(ub1(nw.x), ub1(dw.x)); acc[ai][0][m][0][2] *= PG8_R8(ub2(nw.x), ub2(dw.x)); acc[ai][0][m][0][3] *= PG8_R8(ub3(nw.x), ub3(dw.x));
                acc[ai][0][m][1][0] *= PG8_R8(ub0(nw.y), ub0(dw.y)); acc[ai][0][m][1][1] *= PG8_R8(ub1(nw.y), ub1(dw.y)); acc[ai][0][m][1][2] *= PG8_R8(ub2(nw.y), ub2(dw.y)); acc[ai][0][m][1][3] *= PG8_R8(ub3(nw.y), ub3(dw.y));
                acc[ai][1][m][0][0] *= PG8_R8(ub0(nw.z), ub0(dw.z)); acc[ai][1][m][0][1] *= PG8_R8(ub1(nw.z), ub1(dw.z)); acc[ai][1][m][0][2] *= PG8_R8(ub2(nw.z), ub2(dw.z)); acc[ai][1][m][0][3] *= PG8_R8(ub3(nw.z), ub3(dw.z));
                acc[ai][1][m][1][0] *= PG8_R8(ub0(nw.w), ub0(dw.w)); acc[ai][1][m][1][1] *= PG8_R8(ub1(nw.w), ub1(dw.w)); acc[ai][1][m][1][2] *= PG8_R8(ub2(nw.w), ub2(dw.w)); acc[ai][1][m][1][3] *= PG8_R8(ub3(nw.w), ub3(dw.w));
#undef PG8_R8
                if (m == 3) asm volatile("" ::: "memory"); }
    }
    __device__ __forceinline__ void operator()(const f32x4 (&acc)[2][2][4][2], const Unit& u, int wr, int wc, int fr, int fq) const {
        const int row0 = u.pm * BM + wr * 64 + fr, col0 = u.pn * BM + wc * 64 + 16 * fq; const float k = 1.0f / 255.0f;
#pragma unroll
        for (int ai = 0; ai < 2; ++ai)
#pragma unroll
            for (int m = 0; m < 4; ++m) { const size_t row = (size_t)(row0 + ai * HALF + m * 16);
                const u32x4 gw = *(const u32x4*)(G8 + 4096 + row * ldg8 + col0);
                const f32x4 a0 = acc[ai][0][m][0], a1 = acc[ai][0][m][1], b0 = acc[ai][1][m][0], b1 = acc[ai][1][m][1];
                u32x4 w0, w1;
                w0.x = cvt_pk_bf16(ub0(gw.x) * k * a0[0], ub1(gw.x) * k * a0[1]); w0.y = cvt_pk_bf16(ub2(gw.x) * k * a0[2], ub3(gw.x) * k * a0[3]);
                w0.z = cvt_pk_bf16(ub0(gw.y) * k * a1[0], ub1(gw.y) * k * a1[1]); w0.w = cvt_pk_bf16(ub2(gw.y) * k * a1[2], ub3(gw.y) * k * a1[3]);
                w1.x = cvt_pk_bf16(ub0(gw.z) * k * b0[0], ub1(gw.z) * k * b0[1]); w1.y = cvt_pk_bf16(ub2(gw.z) * k * b0[2], ub3(gw.z) * k * b0[3]);
                w1.z = cvt_pk_bf16(ub0(gw.w) * k * b1[0], ub1(gw.w) * k * b1[1]); w1.w = cvt_pk_bf16(ub2(gw.w) * k * b1[2], ub3(gw.w) * k * b1[3]);
                bf16_t* mp = MIX + row * ldm + col0; *(u32x4*)mp = w0; *(u32x4*)(mp + 8) = w1; }
    }
};
struct EpiResid {
    static constexpr int PERM = 2; static constexpr bool AFTER_DRAIN = false, IDEMPOTENT = false; static constexpr bool HOOKS = false; static constexpr int HOOK_T0 = -1, HOOK_T1 = -1;
    bf16_t* xb; float* part; int ldc; int partld;
    __device__ __forceinline__ void operator()(const f32x4 (&acc)[2][2][4][2], const Unit& u, int wr, int wc, int fr, int fq) const {
        const int row0 = u.pm * BM + wr * 64 + fr, col0 = u.pn * BM + wc * 64 + 16 * fq;
#pragma unroll
        for (int ai = 0; ai < 2; ++ai)
#pragma unroll
            for (int m = 0; m < 4; ++m) { const int row = row0 + ai * HALF + m * 16; bf16_t* xp = xb + (size_t)row * ldc + col0; float q = 0.f;
#pragma unroll
                for (int bj = 0; bj < 2; ++bj) { const u32x4 b = *(const u32x4*)(xp + bj * 8); const f32x4 a0 = acc[ai][bj][m][0], a1 = acc[ai][bj][m][1];
                    u32x4 w; w.x = cvt_pk_bf16(bflo(b.x) + a0[0], bfhi(b.x) + a0[1]); w.y = cvt_pk_bf16(bflo(b.y) + a0[2], bfhi(b.y) + a0[3]);
                    w.z = cvt_pk_bf16(bflo(b.z) + a1[0], bfhi(b.z) + a1[1]); w.w = cvt_pk_bf16(bflo(b.w) + a1[2], bfhi(b.w) + a1[3]);
                    *(u32x4*)(xp + bj * 8) = w;
                    const float r0 = bflo(w.x), r1 = bfhi(w.x), r2 = bflo(w.y), r3 = bfhi(w.y), r4 = bflo(w.z), r5 = bfhi(w.z), r6 = bflo(w.w), r7 = bfhi(w.w);
                    q += (r0 * r0 + r1 * r1) + (r2 * r2 + r3 * r3) + (r4 * r4 + r5 * r5) + (r6 * r6 + r7 * r7); }
                q += __shfl_xor(q, 16); q += __shfl_xor(q, 32);
                if (fq == 0) part[(size_t)(u.pn * 4 + wc) * partld + row] = q; }
    }
};
struct EpiSwiglu {
    static constexpr bool PERM = true, AFTER_DRAIN = false, IDEMPOTENT = true; static constexpr bool HOOKS = false; static constexpr int HOOK_T0 = -1, HOOK_T1 = -1;
    bf16_t* O; int ldc; const PG8_LAS float* rsl;
    __device__ __forceinline__ void operator()(const f32x4 (&acc)[2][2][4][2], const Unit& u, int wr, int wc, int fr, int fq) const {
        const int rl0 = wr * 64 + fr, row0 = u.pm * BM + rl0, col0 = u.pn * HALF + wc * 32 + 8 * fq;
#pragma unroll
        for (int ai = 0; ai < 2; ++ai)
#pragma unroll
            for (int m = 0; m < 4; ++m) { const int row = row0 + ai * HALF + m * 16; bf16_t* rowp = O + (size_t)row * ldc + col0;
                const float rs = rsl[rl0 + ai * HALF + m * 16], rs2 = rs * -1.4426950408889634f, rsq = rs * rs;
                const f32x4 o0 = (acc[ai][0][m][0] * acc[ai][1][m][0]) * rsq * rsig2_(acc[ai][0][m][0] * rs2), o1 = (acc[ai][0][m][1] * acc[ai][1][m][1]) * rsq * rsig2_(acc[ai][0][m][1] * rs2);
                u32x4 w; w.x = cvt_pk_bf16(o0[0], o0[1]); w.y = cvt_pk_bf16(o0[2], o0[3]); w.z = cvt_pk_bf16(o1[0], o1[1]); w.w = cvt_pk_bf16(o1[2], o1[3]);
                *(u32x4*)rowp = w; }
    }
};

#ifndef PG8_EREP
#define PG8_EREP 1
#endif
#ifndef PG8_KREP
#define PG8_KREP 1
#endif
template <class Epi, class Sched, bool ALIGN_EPI = false, bool SP2 = false>
__device__ __forceinline__ void gemm_phase(PG8_LAS unsigned char* lds, const Gemm g, const Sched& S, const Epi& E) {
    int tid_ = threadIdx.x; asm volatile("" : "+v"(tid_));
    const int tid = tid_, wid = __builtin_amdgcn_readfirstlane(tid >> 6), lane = tid & 63, wr = wid >> 2, wc = wid & 3, fr = lane & 15, fq = lane >> 4;
    const int K = g.K, nt = K / BK;
    unsigned voffA[2], voffB[2], voffB1[2];
#pragma unroll
    for (int i = 0; i < 2; ++i) { int R, C; stage_rc(tid * 16 + i * 8192, R, C);
        if constexpr (Epi::PERM == 2) {
            const int Rg = 64 * (R >> 5) + 16 * ((R & 15) >> 2) + 4 * ((R >> 4) & 1) + (R & 3);
            voffB[i] = (unsigned)(Rg * g.ldb + C) * 2u; voffB1[i] = (unsigned)((Rg + 8) * g.ldb + C) * 2u;
        } else { const int Rb = Epi::PERM ? ((R & ~31) + perm32(R & 31)) : R; voffB[i] = (unsigned)(Rb * g.ldb + C) * 2u; voffB1[i] = voffB[i]; }
        voffA[i] = (unsigned)(R * g.lda + C) * 2u; }
    const size_t kstep = (size_t)(BK * 2);
    const size_t hstepA = (size_t)HALF * g.lda * 2, hstepB = (Epi::PERM == 2) ? 0 : (size_t)HALF * g.ldb * 2;
    const size_t tstepA = 2 * hstepA, tstepB = (size_t)BM * g.ldb * 2;
    const unsigned ldsw = (unsigned)wid * 1024u;
    const int aoff = lds_byte(wr * 64 + fr, fq * 8), boff = lds_byte(wc * 32 + fr, fq * 8);
#define PG8_SA(b, h) (((b) * 2 + (h)) * HTB)
#define PG8_SB(b, h) ((4 + (b) * 2 + (h)) * HTB)
#define PG8_STAGE(bufoff, gbase, voff) do { _Pragma("unroll") for (int _i = 0; _i < 2; ++_i) \
        __builtin_amdgcn_global_load_lds((const unsigned*)((const char*)(gbase) + (voff)[_i]), (PG8_LAS unsigned*)(lds + (bufoff) + ldsw + _i * 8192), 16, 0, 0); } while (0)
#define PG8_LDA(dst, b, h) do { _Pragma("unroll") for (int m = 0; m < 4; ++m) _Pragma("unroll") for (int k = 0; k < 2; ++k) dst[m][k] = *(const PG8_LAS bf16x8*)(lds + PG8_SA(b, h) + aoff + m * 2048 + k * 1024); } while (0)
#define PG8_LDB(dst, b, h) do { _Pragma("unroll") for (int n = 0; n < 2; ++n) _Pragma("unroll") for (int k = 0; k < 2; ++k) dst[n][k] = *(const PG8_LAS bf16x8*)(lds + PG8_SB(b, h) + boff + n * 2048 + k * 1024); } while (0)
#define PG8_MMA(ai, bj, At, Bt) do { __builtin_amdgcn_s_setprio(1); _Pragma("unroll") for (int m = 0; m < 4; ++m) _Pragma("unroll") for (int n = 0; n < 2; ++n) _Pragma("unroll") for (int k = 0; k < 2; ++k) \
        acc[ai][bj][m][n] = __builtin_amdgcn_mfma_f32_16x16x32_bf16(Bt[n][k], At[m][k], acc[ai][bj][m][n], 0, 0, 0); __builtin_amdgcn_s_setprio(0); } while (0)
#define PG8_WAIT_V(n) asm volatile("s_waitcnt vmcnt(" #n ")" ::: "memory")
#define PG8_WAIT_L(n) asm volatile("s_waitcnt lgkmcnt(" #n ")" ::: "memory")
#define PG8_BAR __builtin_amdgcn_s_barrier()
#define PG8_SCHED __builtin_amdgcn_sched_barrier(0)
    Unit cur, nxt; int ui = 0;
    if (!S.next(0, cur)) return;
    f32x4 acc[2][2][4][2];
#pragma unroll
    for (int a = 0; a < 2; ++a)
#pragma unroll
        for (int b = 0; b < 2; ++b)
#pragma unroll
            for (int m = 0; m < 4; ++m)
#pragma unroll
                for (int n = 0; n < 2; ++n) acc[a][b][m][n] = (f32x4){0.f, 0.f, 0.f, 0.f};
    bf16x8 At[4][2], B0[2][2], B1[2][2];
    const char* cA = (const char*)g.A + (size_t)cur.pm * tstepA; const char* cB = (const char*)g.Bt + (size_t)cur.pn * tstepB;
    S.a_ready(cur);
    if constexpr (SP2) {
        PG8_STAGE(PG8_SB(0, 0), cB, voffB); PG8_STAGE(PG8_SB(0, 1), cB + hstepB, voffB1); PG8_STAGE(PG8_SA(0, 0), cA, voffA); PG8_STAGE(PG8_SA(0, 1), cA + hstepA, voffA);
        if (wr == 1) PG8_BAR;
        PG8_WAIT_V(2); PG8_BAR;
        PG8_STAGE(PG8_SB(1, 0), cB + kstep, voffB); PG8_STAGE(PG8_SA(1, 0), cA + kstep, voffA); PG8_STAGE(PG8_SB(1, 1), cB + hstepB + kstep, voffB1);
        PG8_WAIT_V(6); PG8_BAR;
    } else {
        PG8_STAGE(PG8_SB(0, 0), cB, voffB); PG8_STAGE(PG8_SA(0, 0), cA, voffA); PG8_STAGE(PG8_SB(0, 1), cB + hstepB, voffB1); PG8_STAGE(PG8_SA(0, 1), cA + hstepA, voffA);
        if (wr == 1) PG8_BAR;
        PG8_WAIT_V(4); PG8_BAR;
        PG8_STAGE(PG8_SB(1, 0), cB + kstep, voffB); PG8_STAGE(PG8_SA(1, 0), cA + kstep, voffA); PG8_STAGE(PG8_SB(1, 1), cB + hstepB + kstep, voffB1);
        PG8_WAIT_V(6); PG8_BAR;
    }
    for (;;) {
        const bool has_next = S.next(ui + 1, nxt);
        const char* nA = has_next ? (const char*)g.A + (size_t)nxt.pm * tstepA : cA; const char* nB = has_next ? (const char*)g.Bt + (size_t)nxt.pn * tstepB : cB;
        for (int kr = 0; kr < PG8_KREP; ++kr)
        for (int t = 0; t < nt; t += 2) {
            const bool lastp = (t == nt - 2), last = lastp && (kr == PG8_KREP - 1);
            if constexpr (Epi::HOOKS) { if (t == Epi::HOOK_T0 || t == Epi::HOOK_T1) E.hook(acc, cur, wr, wc, fr, fq, t == Epi::HOOK_T0 ? 0 : 1); }
            const char* a1 = cA + (size_t)(t + 1) * kstep;
            const char* a2 = last ? nA : (lastp ? cA : cA + (size_t)(t + 2) * kstep); const char* b2 = last ? nB : (lastp ? cB : cB + (size_t)(t + 2) * kstep);
            const char* a3 = a2 + kstep; const char* b3 = b2 + kstep;
            if (last && has_next) S.a_ready(nxt);
            if constexpr (SP2) {
            PG8_LDB(B0, 0, 0); PG8_LDB(B1, 0, 1); PG8_SCHED; PG8_LDA(At, 0, 0); PG8_STAGE(PG8_SA(1, 1), a1 + hstepA, voffA);
            PG8_WAIT_V(8); PG8_WAIT_L(0); PG8_BAR; PG8_MMA(0, 0, At, B0); PG8_MMA(0, 1, At, B1); PG8_BAR; PG8_SCHED;
            PG8_LDA(At, 0, 1); PG8_STAGE(PG8_SB(0, 0), b2, voffB); PG8_STAGE(PG8_SB(0, 1), b2 + hstepB, voffB1); PG8_STAGE(PG8_SA(0, 0), a2, voffA);
            PG8_WAIT_V(8); PG8_WAIT_L(0); PG8_BAR; PG8_MMA(1, 0, At, B0); PG8_MMA(1, 1, At, B1); PG8_BAR; PG8_SCHED;
            PG8_LDB(B0, 1, 0); PG8_LDB(B1, 1, 1); PG8_SCHED; PG8_LDA(At, 1, 0); PG8_STAGE(PG8_SA(0, 1), a2 + hstepA, voffA);
            PG8_WAIT_V(8); PG8_WAIT_L(0); PG8_BAR; PG8_MMA(0, 0, At, B0); PG8_MMA(0, 1, At, B1); PG8_BAR; PG8_SCHED;
            PG8_LDA(At, 1, 1); PG8_STAGE(PG8_SB(1, 0), b3, voffB); PG8_STAGE(PG8_SB(1, 1), b3 + hstepB, voffB1); PG8_STAGE(PG8_SA(1, 0), a3, voffA);
            PG8_WAIT_V(8); PG8_WAIT_L(0); PG8_BAR; PG8_MMA(1, 0, At, B0); PG8_MMA(1, 1, At, B1); PG8_BAR; PG8_SCHED;
            } else {
            PG8_LDB(B0, 0, 0); PG8_SCHED; PG8_LDA(At, 0, 0); PG8_STAGE(PG8_SA(1, 1), a1 + hstepA, voffA);
            PG8_WAIT_L(8); PG8_BAR; PG8_WAIT_L(0); PG8_MMA(0, 0, At, B0); PG8_BAR; PG8_SCHED;
            PG8_LDB(B1, 0, 1); PG8_STAGE(PG8_SB(0, 0), b2, voffB);
            PG8_BAR; PG8_WAIT_L(0); PG8_MMA(0, 1, At, B1); PG8_BAR;
            PG8_LDA(At, 0, 1); PG8_STAGE(PG8_SA(0, 0), a2, voffA);
            PG8_BAR; PG8_WAIT_L(0); PG8_MMA(1, 0, At, B0); PG8_BAR; PG8_SCHED;
            PG8_STAGE(PG8_SB(0, 1), b2 + hstepB, voffB1);
            PG8_WAIT_V(6); PG8_BAR; PG8_MMA(1, 1, At, B1); PG8_BAR;
            PG8_LDB(B0, 1, 0); PG8_SCHED; PG8_LDA(At, 1, 0); PG8_STAGE(PG8_SA(0, 1), a2 + hstepA, voffA);
            PG8_WAIT_L(8); PG8_BAR; PG8_WAIT_L(0); PG8_MMA(0, 0, At, B0); PG8_BAR; PG8_SCHED;
            PG8_LDB(B1, 1, 1); PG8_STAGE(PG8_SB(1, 0), b3, voffB);
            PG8_BAR; PG8_WAIT_L(0); PG8_MMA(0, 1, At, B1); PG8_BAR;
            PG8_LDA(At, 1, 1); PG8_STAGE(PG8_SA(1, 0), a3, voffA);
            PG8_BAR; PG8_WAIT_L(0); PG8_MMA(1, 0, At, B0); PG8_BAR; PG8_SCHED;
            PG8_STAGE(PG8_SB(1, 1), b3 + hstepB, voffB1);
            PG8_WAIT_V(6); PG8_BAR; PG8_MMA(1, 1, At, B1); PG8_BAR;
            }
        }
        if (PG8_KREP > 1) {
#pragma unroll
            for (int a = 0; a < 2; ++a)
#pragma unroll
                for (int b = 0; b < 2; ++b)
#pragma unroll
                    for (int m = 0; m < 4; ++m)
#pragma unroll
                        for (int n = 0; n < 2; ++n) acc[a][b][m][n] = acc[a][b][m][n] * (1.0f / PG8_KREP); }
        if constexpr (ALIGN_EPI) { if (wr == 0) PG8_BAR; }
        if constexpr (!Epi::AFTER_DRAIN) { E(acc, cur, wr, wc, fr, fq); if (PG8_EREP > 1 && Epi::IDEMPOTENT) { asm volatile("" ::: "memory"); E(acc, cur, wr, wc, fr, fq); } S.done(cur); }
        if (!has_next) break;
#pragma unroll
        for (int a = 0; a < 2; ++a)
#pragma unroll
            for (int b = 0; b < 2; ++b)
#pragma unroll
                for (int m = 0; m < 4; ++m)
#pragma unroll
                    for (int n = 0; n < 2; ++n) acc[a][b][m][n] = (f32x4){0.f, 0.f, 0.f, 0.f};
        cur = nxt; cA = nA; cB = nB; ++ui;
        if constexpr (ALIGN_EPI) { if (wr == 1) PG8_BAR; }
    }
    PG8_WAIT_V(0);
    if constexpr (!ALIGN_EPI) { if (wr == 0) PG8_BAR; }
    PG8_BAR;
    if constexpr (Epi::AFTER_DRAIN) { E.fused(acc, cur, wr, wc, fr, fq, lds, wid, lane); S.done(cur); }
#undef PG8_SA
#undef PG8_SB
#undef PG8_STAGE
#undef PG8_LDA
#undef PG8_LDB
#undef PG8_MMA
#undef PG8_WAIT_V
#undef PG8_WAIT_L
#undef PG8_BAR
#undef PG8_SCHED
}
}

constexpr int D = 2048, DEPTH = 4, DIN = 13824, DFF = 5632, DGU = 2 * DFF;
constexpr int TOK = 49152, GT = 16384, NG = 3;
constexpr int CONVD = 512, NAD = 768, HGD = 768, NAH = 12, HGH = 6;
constexpr int DINP = DIN - NAD;
constexpr int C_AH = 0, C_AB = 512, C_AC = 1024, C_NQ = 1536, C_NK = 2304, C_CQ = 3072, C_CFF = 3840, C_CFB = 4608, C_CI = 5376, C_CG = 6144, C_GA = 6912;
constexpr float EPS = 1e-6f;
constexpr int NWAVES = 8;

constexpr size_t MiB = 1u << 20;
constexpr size_t WS_CTL = 0, CTL_ZERO_BYTES = 1 * MiB;
constexpr size_t WS_LB = 4 * MiB;
constexpr size_t WS_W = 5 * MiB;
constexpr size_t LW_IN = 0, LW_BC = LW_IN + (size_t)DIN * D * 2, LW_BA = LW_BC + (size_t)D * CONVD * 2, LW_BH = LW_BA + (size_t)D * NAD * 2, LW_MO = LW_BH + (size_t)D * HGD * 2,
                 LW_GU = LW_MO + (size_t)D * D * 2, LW_D = LW_GU + (size_t)DGU * D * 2, LW = LW_D + (size_t)D * DFF * 2;
static_assert(LW == 136 * MiB, "per-layer weight bytes");
constexpr size_t WS_H = WS_W + DEPTH * LW;
constexpr size_t WS_Y = WS_H + (size_t)GT * D * 2;
constexpr size_t WS_P = WS_Y + (size_t)GT * D * 2;
constexpr size_t WS_OF = WS_P + (size_t)GT * DIN * 2;
constexpr size_t WS_OB = WS_OF + (size_t)GT * HGD * 4;
constexpr size_t WS_SLOC = WS_OB + (size_t)GT * HGD * 4;
constexpr size_t WS_DTOT = WS_SLOC + (size_t)42 * 6 * 2 * 65536;
constexpr size_t WS_VT = WS_DTOT + 1 * MiB;
constexpr size_t WS_XB = WS_VT + (size_t)NAD * GT * 2;
constexpr size_t WS_PART = WS_XB + (size_t)GT * D * 2;
constexpr size_t WS_RS = WS_PART + (size_t)2 * GT * 32 * 4;
constexpr size_t WS_G8 = WS_RS + 1 * MiB;
constexpr size_t WS_END = WS_G8 + (size_t)GT * 6144;
constexpr int CW_TMO = 0, CW_BAR = 4096;
constexpr int CW_PANEL = 196608, CW_XCC = 200704, CW_MISM = 201216;

constexpr int RING_OFF = 0, RING_BYTES = 131072;
constexpr int LDSCTL_OFF = RING_BYTES, MISC_OFF = LDSCTL_OFF + 320, RSL_OFF = LDSCTL_OFF + 1024;
constexpr int LDS_BYTES = 147456;

#define GAS __attribute__((address_space(1)))
#define LAS __attribute__((address_space(3)))
typedef unsigned short bf16;
typedef unsigned v4u __attribute__((ext_vector_type(4)));
typedef unsigned v2u __attribute__((ext_vector_type(2)));
typedef float f32x4 __attribute__((ext_vector_type(4)));
typedef GAS unsigned gu32;
#define RLX_AGENT __ATOMIC_RELAXED, __HIP_MEMORY_SCOPE_AGENT
#define LDS_WAIT() asm volatile("s_waitcnt lgkmcnt(0)" ::: "memory")
#define VM_WAIT() asm volatile("s_waitcnt vmcnt(0)" ::: "memory")
__device__ __forceinline__ unsigned f2bf(float f) { unsigned u = __builtin_bit_cast(unsigned, f); return (u + 0x7fffu + ((u >> 16) & 1u)) >> 16; }
__device__ __forceinline__ unsigned pk2(float lo, float hi) { return f2bf(lo) | (f2bf(hi) << 16); }
__device__ __forceinline__ float bf2f(bf16 b) { return __uint_as_float(((unsigned)b) << 16); }
__device__ __forceinline__ float bflo(unsigned w) { return __uint_as_float(w << 16); }
__device__ __forceinline__ float bfhi(unsigned w) { return __uint_as_float(w & 0xffff0000u); }
__device__ __forceinline__ float sigm(float x) { return 1.0f / (1.0f + __expf(-x)); }
__device__ __forceinline__ float silu(float x) { return x / (1.0f + __expf(-x)); }

#define XB_TMO      128
#define XB_XCNT(j)  (256  + 64 * (j))
#define XB_XSUB(j)  (1280 + 64 * (j))
#define XB_XGEN(j)  (2304 + 64 * (j))
#define XB_TOP      3328
#define XB_TOPGEN   3392
#define XCD_BAR_WORDS 3456
#define XB_SPIN_CAP (1u << 18)

__device__ __forceinline__ unsigned xb_ld(unsigned* p)              { return __hip_atomic_load(p, __ATOMIC_RELAXED, __HIP_MEMORY_SCOPE_AGENT); }
__device__ __forceinline__ unsigned xb_add(unsigned* p, unsigned v) { return __hip_atomic_fetch_add(p, v, __ATOMIC_RELAXED, __HIP_MEMORY_SCOPE_AGENT); }
__device__ __forceinline__ unsigned xb_xcc_id() { return (unsigned)__builtin_amdgcn_s_getreg((3 << 11) | 20) & 0xFu; }
#define XB_SPIN(cond, bar) do { unsigned _sp = 0; while (cond) { __builtin_amdgcn_s_sleep(1); \
    if ((++_sp & 255u) == 0u) { if (xb_ld(&(bar)[XB_TMO])) break; if (_sp > XB_SPIN_CAP) { atomicAdd(&(bar)[XB_TMO], 1u); break; } } } } while (0)

struct XcdBarrier {
    unsigned* bar; unsigned x;
    volatile LAS unsigned* st;
};

__device__ __forceinline__ XcdBarrier xcd_barrier_post(unsigned* bar, volatile LAS unsigned* st) {
    XcdBarrier b; b.bar = bar; b.x = xb_xcc_id(); b.st = st;
    if (threadIdx.x == 0) (void)xb_add(&bar[XB_XCNT(b.x)], 1u);
    return b;
}
__device__ __forceinline__ void xcd_barrier_complete(unsigned* bar, unsigned x, unsigned& nloc, unsigned& nx) {
    const unsigned G = gridDim.x * gridDim.y * gridDim.z;
    unsigned sum, cnt, mine, sp = 0u;
    for (;;) {
        sum = 0u; cnt = 0u; mine = 0u;
#pragma unroll
        for (unsigned j = 0; j < 16; ++j) { const unsigned c = xb_ld(&bar[XB_XCNT(j)]); sum += c; cnt += (c > 0u) ? 1u : 0u; mine = (j == x) ? c : mine; }
        if (sum == G) break;
        __builtin_amdgcn_s_sleep(1);
        if ((++sp & 255u) == 0u) { if (xb_ld(&bar[XB_TMO])) break; if (sp > XB_SPIN_CAP) { atomicAdd(&bar[XB_TMO], 1u); break; } }
    }
    nloc = mine > 0u ? mine : 1u; nx = cnt > 0u ? cnt : 1u;
}

__device__ __forceinline__ void xcd_barrier(const XcdBarrier& b) {
    asm volatile("s_waitcnt vmcnt(0)" ::: "memory");
    __syncthreads();
    if (threadIdx.x == 0) {
        unsigned* bar = b.bar;
        __builtin_amdgcn_s_waitcnt(0);
        unsigned nloc = b.st[0], nx = b.st[1];
        if (nloc == 0u) { xcd_barrier_complete(bar, b.x, nloc, nx); b.st[0] = nloc; b.st[1] = nx; }
        const unsigned old = xb_add(&bar[XB_XSUB(b.x)], 1u);
        const unsigned gen = old / nloc;
        if (old + 1u == (gen + 1u) * nloc) {
            __builtin_amdgcn_fence(__ATOMIC_RELEASE, "agent");
            asm volatile("s_waitcnt vmcnt(0)" ::: "memory");
            const unsigned og = xb_add(&bar[XB_TOP], 1u);
            const unsigned tg = og / nx;
            if (og + 1u == (tg + 1u) * nx) xb_add(&bar[XB_TOPGEN], 1u);
            else XB_SPIN(xb_ld(&bar[XB_TOPGEN]) == tg, bar);
            __builtin_amdgcn_fence(__ATOMIC_ACQUIRE, "agent");
            xb_add(&bar[XB_XGEN(b.x)], 1u);
            asm volatile("s_waitcnt vmcnt(0)" ::: "memory");
        } else {
            XB_SPIN(xb_ld(&bar[XB_XGEN(b.x)]) == gen, bar);
            __builtin_amdgcn_fence(__ATOMIC_ACQUIRE, "agent");
            asm volatile("s_waitcnt vmcnt(0)" ::: "memory");
        }
    }
    __syncthreads();
}

struct Frame {
    LAS unsigned char* lds;
    volatile LAS unsigned* MISC;
};
#define CAS __attribute__((address_space(4)))
__device__ __forceinline__ const CAS unsigned char* karg_ptr() { const CAS unsigned char* kp = (const CAS unsigned char*)__builtin_amdgcn_kernarg_segment_ptr(); asm volatile("" : "+s"(kp)); return kp; }
__device__ __forceinline__ const float* arg_in(int i) { return *(const float* const CAS*)(karg_ptr() + 8 * i); }
__device__ __forceinline__ float* arg_out() { return *(float* const CAS*)(karg_ptr() + 8 * 17); }
__device__ __forceinline__ unsigned char* arg_ws() { return *(unsigned char* const CAS*)(karg_ptr() + 8 * 18); }
__device__ __forceinline__ int opaque_tid() { int t = threadIdx.x; asm volatile("" : "+v"(t)); return t; }
__device__ __forceinline__ int opaque_bid() { int b = blockIdx.x; asm volatile("" : "+s"(b)); return b; }
__device__ __forceinline__ int opaque_G() { int g = gridDim.x; asm volatile("" : "+s"(g)); return g; }
__device__ __forceinline__ void panel_barrier(Frame& F, int pm) {
    asm volatile("s_waitcnt vmcnt(0)" ::: "memory");
    __syncthreads();
    unsigned* w = (unsigned*)(arg_ws() + WS_CTL);
    if (opaque_tid() == 0) {
        __builtin_amdgcn_s_waitcnt(0);
        unsigned* ctr = w + CW_PANEL + pm * 32;
        const unsigned ep = F.MISC[105] + 1u; F.MISC[105] = ep;
        (void)xb_add(ctr, 1u);
        XB_SPIN(xb_ld(ctr) < 4u * ep, w + CW_BAR);
        __builtin_amdgcn_fence(__ATOMIC_ACQUIRE, "agent");
        asm volatile("s_waitcnt vmcnt(0)" ::: "memory");
    }
    __syncthreads();
}
__device__ __forceinline__ float wave_sum(float v) {
#pragma unroll
    for (int o = 1; o < 64; o <<= 1) v += __shfl_xor(v, o);
    return v;
}

constexpr int P0_PITCH = 68;
template <int MAP>
__device__ __forceinline__ void p0_transpose_item(const float* W, int K, int N, bf16* WT, const float* gk, LAS float* scr, int item, int lane, int dpitch = 0, int koff = 0) {
    if (dpitch == 0) dpitch = K;
    const int nblk = N / 64, kb = item / nblk, nb = item % nblk, k0 = 32 * kb, n0 = 64 * nb;
    const int lr = lane >> 4, ln = (lane & 15) * 4;
#pragma unroll
    for (int i = 0; i < 8; ++i) { const int kk = 4 * i + lr; f32x4 w = *(const GAS f32x4*)(W + (size_t)(k0 + kk) * N + n0 + ln); if (gk) w = w * gk[k0 + kk];
        *(LAS f32x4*)(scr + kk * P0_PITCH + ln) = w; }
    LDS_WAIT(); asm volatile("" ::: "memory");
    const int c = lane & 3;
    const int drow0 = (MAP == 0) ? n0 : (MAP == 3) ? (n0 < 3072 ? n0 : (n0 < 3840 ? n0 + (DINP - 3072) : n0 - NAD)) : ((n0 >> 7) * 256 + (MAP == 2 ? 128 : 0) + (n0 & 127));
#pragma unroll
    for (int j = 0; j < 4; ++j) { const int n = (lane >> 2) + 16 * j; const LAS float* s = scr + (8 * c) * P0_PITCH + n;
        v4u o; o.x = pk2(s[0 * P0_PITCH], s[1 * P0_PITCH]); o.y = pk2(s[2 * P0_PITCH], s[3 * P0_PITCH]); o.z = pk2(s[4 * P0_PITCH], s[5 * P0_PITCH]); o.w = pk2(s[6 * P0_PITCH], s[7 * P0_PITCH]);
        *(GAS v4u*)(WT + (size_t)(drow0 + n) * dpitch + koff + k0 + 8 * c) = o; }
    LDS_WAIT(); asm volatile("" ::: "memory");
}
__device__ __forceinline__ void p0_prologue(Frame& F) {
    const int tid = opaque_tid(), lane = tid & 63, wave = __builtin_amdgcn_readfirstlane(tid >> 6);
    LAS float* scr = (LAS float*)(F.lds + RING_OFF + wave * 16384);
    const int gw = opaque_bid() * NWAVES + wave, NGW = opaque_G() * NWAVES;
    constexpr int I_IN = (D / 32) * (DIN / 64), I_BC = (CONVD / 32) * (D / 64), I_BA = (NAD / 32) * (D / 64), I_BH = (HGD / 32) * (D / 64), I_MO = (D / 32) * (D / 64),
                  I_G = (D / 32) * (DFF / 64), I_D = (DFF / 32) * (D / 64), I_L = I_IN + I_BC + I_BA + I_BH + I_MO + 2 * I_G + I_D;
    for (int it = gw; it < DEPTH * I_L; it += NGW) {
        const int l = it / I_L; int r = it - l * I_L;
        bf16* wl = (bf16*)(arg_ws() + WS_W + (size_t)l * LW);
        if (r < I_IN) { p0_transpose_item<3>(arg_in(3) + (size_t)l * D * DIN, D, DIN, wl + LW_IN / 2, arg_in(2) + l * D, scr, r, lane); continue; } r -= I_IN;
        if (r < I_BC) { p0_transpose_item<0>(arg_in(8) + (size_t)l * CONVD * D, CONVD, D, wl + LW_BC / 2, nullptr, scr, r, lane, D, 0); continue; } r -= I_BC;
        if (r < I_BA) { p0_transpose_item<0>(arg_in(9) + (size_t)l * NAD * D, NAD, D, wl + LW_BC / 2, nullptr, scr, r, lane, D, CONVD); continue; } r -= I_BA;
        if (r < I_BH) { p0_transpose_item<0>(arg_in(10) + (size_t)l * HGD * D, HGD, D, wl + LW_BC / 2, nullptr, scr, r, lane, D, CONVD + NAD); continue; } r -= I_BH;
        if (r < I_MO) { p0_transpose_item<0>(arg_in(11) + (size_t)l * D * D, D, D, wl + LW_MO / 2, nullptr, scr, r, lane); continue; } r -= I_MO;
        if (r < I_G) { p0_transpose_item<1>(arg_in(13) + (size_t)l * D * DFF, D, DFF, wl + LW_GU / 2, arg_in(12) + l * D, scr, r, lane); continue; } r -= I_G;
        if (r < I_G) { p0_transpose_item<2>(arg_in(14) + (size_t)l * D * DFF, D, DFF, wl + LW_GU / 2, arg_in(12) + l * D, scr, r, lane); continue; } r -= I_G;
        p0_transpose_item<0>(arg_in(15) + (size_t)l * DFF * D, DFF, D, wl + LW_D / 2, nullptr, scr, r, lane);
    }
    const int gt = opaque_bid() * (NWAVES * 64) + tid;
    if (gt < 2 * HGD) {
        const float* hl = arg_in(6); float v[DEPTH]; float mx = -3.4e38f;
#pragma unroll
        for (int l = 0; l < DEPTH; ++l) { v[l] = hl[l * 2 * HGD + gt]; mx = fmaxf(mx, v[l]); }
        float s = 0.f;
#pragma unroll
        for (int l = 0; l < DEPTH; ++l) { v[l] = expf(v[l] - mx); s += v[l]; }
        float* LB = (float*)(arg_ws() + WS_LB); float c = 0.f;
#pragma unroll
        for (int l = 0; l < DEPTH; ++l) { const float sm = v[l] / s; c += sm; LB[l * 2 * HGD + gt] = (l == 0) ? 0.f : c - v[0] / s; }
    }
}

__device__ __forceinline__ void x_rows_prepare(Frame& F, const float* x, bf16* o, float* ss, int rows, int own) {
    const int tid = opaque_tid(), lane = tid & 63, wave = __builtin_amdgcn_readfirstlane(tid >> 6);
    const int gw = own >= 0 ? own + wave : opaque_bid() * NWAVES + wave, NGW = own >= 0 ? NWAVES : opaque_G() * NWAVES, mend = own >= 0 ? own + 64 : rows;
    for (int m = gw; m < mend; m += NGW) {
        const GAS f32x4* xr = (const GAS f32x4*)(x + (size_t)m * D) + lane;
        f32x4 v[8]; float s = 0.f;
#pragma unroll
        for (int j = 0; j < 8; ++j) v[j] = xr[64 * j];
        GAS v2u* o8 = (GAS v2u*)(o + (size_t)m * D) + lane;
#pragma unroll
        for (int j = 0; j < 8; ++j) { v2u w; w.x = pk2(v[j].x, v[j].y); w.y = pk2(v[j].z, v[j].w); o8[64 * j] = w;
            const float r0 = bflo(w.x), r1 = bfhi(w.x), r2 = bflo(w.y), r3 = bfhi(w.y); s += (r0 * r0 + r1 * r1) + (r2 * r2 + r3 * r3); }
        s = wave_sum(s);
        if (lane < 32) ss[(size_t)lane * GT + m] = (lane == 0) ? s : 0.f;
    }
}
__device__ __forceinline__ void norm_rows_final(Frame& F, const bf16* xb, float* out, const float* gain, int rows, int own) {
    const int tid = opaque_tid(), lane = tid & 63, wave = __builtin_amdgcn_readfirstlane(tid >> 6);
    const int gw = own >= 0 ? own + wave : opaque_bid() * NWAVES + wave, NGW = own >= 0 ? NWAVES : opaque_G() * NWAVES, mend = own >= 0 ? own + 64 : rows;
    for (int m = gw; m < mend; m += NGW) {
        const GAS v4u* xr = (const GAS v4u*)(xb + (size_t)m * D) + lane; GAS f32x4* orow = (GAS f32x4*)(out + (size_t)m * D); const GAS f32x4* gr = (const GAS f32x4*)gain;
        v4u w[4]; float s = 0.f;
#pragma unroll
        for (int j = 0; j < 4; ++j) { w[j] = xr[64 * j];
            const float r0 = bflo(w[j].x), r1 = bfhi(w[j].x), r2 = bflo(w[j].y), r3 = bfhi(w[j].y), r4 = bflo(w[j].z), r5 = bfhi(w[j].z), r6 = bflo(w[j].w), r7 = bfhi(w[j].w);
            s += (r0 * r0 + r1 * r1) + (r2 * r2 + r3 * r3) + (r4 * r4 + r5 * r5) + (r6 * r6 + r7 * r7); }
        const float rs = 1.0f / sqrtf(wave_sum(s) * (1.f / D) + EPS);
#pragma unroll
        for (int j = 0; j < 4; ++j) { const int c4 = (64 * j + lane) * 2; const f32x4 g0 = gr[c4], g1 = gr[c4 + 1];
            orow[c4] = (f32x4){bflo(w[j].x) * rs * g0.x, bfhi(w[j].x) * rs * g0.y, bflo(w[j].y) * rs * g0.z, bfhi(w[j].y) * rs * g0.w};
            orow[c4 + 1] = (f32x4){bflo(w[j].z) * rs * g1.x, bfhi(w[j].z) * rs * g1.y, bflo(w[j].w) * rs * g1.z, bfhi(w[j].w) * rs * g1.w}; }
    }
}

constexpr int CONV_CH = 16, CW_CONV = 65536;
__device__ __forceinline__ void conv_phase(Frame& F, const bf16* P, bf16* Y, const float* cw, int L, unsigned* ctr) {
    const int tid_ = opaque_tid();
    const int ch = (tid_ & 63) * 8;
    volatile LAS int* slot = (volatile LAS int*)(F.lds + LDSCTL_OFF + 768);
    if (tid_ == 0) slot[0] = (int)__hip_atomic_fetch_add(ctr, 1u, __ATOMIC_RELAXED, __HIP_MEMORY_SCOPE_AGENT);
    __syncthreads();
    int cur = slot[0], par = 0;
    const f32x4 w0a = *(const GAS f32x4*)(cw + ch), w0b = *(const GAS f32x4*)(cw + ch + 4), w1a = *(const GAS f32x4*)(cw + 512 + ch), w1b = *(const GAS f32x4*)(cw + 512 + ch + 4),
                w2a = *(const GAS f32x4*)(cw + 1024 + ch), w2b = *(const GAS f32x4*)(cw + 1024 + ch + 4);
    while (cur < GT / CONV_CH) {
    unsigned nxt = 0u; if (tid_ == 0) nxt = __hip_atomic_fetch_add(ctr, 1u, __ATOMIC_RELAXED, __HIP_MEMORY_SCOPE_AGENT);
#pragma unroll
    for (int i_ = 0; i_ < CONV_CH / 8; ++i_) {
        const int t = cur * CONV_CH + i_ * 8 + (tid_ >> 6), pos = t % L;
        const bf16* row = P + (size_t)t * DINP + ch;
        const v4u z4 = (v4u){0u, 0u, 0u, 0u};
        const v4u h1 = *(const GAS v4u*)(row + C_AH), c1 = *(const GAS v4u*)(row + C_AC), b1 = *(const GAS v4u*)(row + C_AB);
        v4u h0 = z4, c0 = z4, h2 = z4, c2 = z4;
        if (pos > 0) { h0 = *(const GAS v4u*)(row - DINP + C_AH); c0 = *(const GAS v4u*)(row - DINP + C_AC); }
        if (pos < L - 1) { h2 = *(const GAS v4u*)(row + DINP + C_AH); c2 = *(const GAS v4u*)(row + DINP + C_AC); }
        float y[8];
#define CONV1(k, hw0, cw0, hw1, cw1, hw2, cw2, bw, W0, W1, W2, e, HL) { const float u0 = HL(hw0) * HL(cw0), u1 = HL(hw1) * HL(cw1), u2 = HL(hw2) * HL(cw2); y[k] = HL(bw) * (u0 * W0[e] + u1 * W1[e] + u2 * W2[e]); }
        CONV1(0, h0.x, c0.x, h1.x, c1.x, h2.x, c2.x, b1.x, w0a, w1a, w2a, 0, bflo) CONV1(1, h0.x, c0.x, h1.x, c1.x, h2.x, c2.x, b1.x, w0a, w1a, w2a, 1, bfhi)
        CONV1(2, h0.y, c0.y, h1.y, c1.y, h2.y, c2.y, b1.y, w0a, w1a, w2a, 2, bflo) CONV1(3, h0.y, c0.y, h1.y, c1.y, h2.y, c2.y, b1.y, w0a, w1a, w2a, 3, bfhi)
        CONV1(4, h0.z, c0.z, h1.z, c1.z, h2.z, c2.z, b1.z, w0b, w1b, w2b, 0, bflo) CONV1(5, h0.z, c0.z, h1.z, c1.z, h2.z, c2.z, b1.z, w0b, w1b, w2b, 1, bfhi)
        CONV1(6, h0.w, c0.w, h1.w, c1.w, h2.w, c2.w, b1.w, w0b, w1b, w2b, 2, bflo) CONV1(7, h0.w, c0.w, h1.w, c1.w, h2.w, c2.w, b1.w, w0b, w1b, w2b, 3, bfhi)
#undef CONV1
        v4u o; o.x = pk2(y[0], y[1]); o.y = pk2(y[2], y[3]); o.z = pk2(y[4], y[5]); o.w = pk2(y[6], y[7]);
        *(GAS v4u*)(Y + (size_t)t * D + ch) = o;
    }
    if (tid_ == 0) slot[par ^ 1] = (int)nxt;
    __syncthreads();
    par ^= 1; cur = slot[par];
    }
}

typedef short s16x4 __attribute__((ext_vector_type(4)));
typedef short s16x8 __attribute__((ext_vector_type(8)));
constexpr int HG_NSEG = 42;
constexpr int HG_QP = 272;
constexpr int OPS_Q = 0, OPS_K = 16 * HG_QP, OPS_KT = 2 * 16 * HG_QP, OPS_D = OPS_KT + 128 * 32, OPS_BUF = OPS_D + 512, OPS_DIR = 2 * OPS_BUF;
static_assert(2 * OPS_DIR <= RING_BYTES, "HGRN operand images fit the ring region");
constexpr size_t HG_FRAG = 4096;

__device__ __forceinline__ float hg_sig(float x) { return __builtin_amdgcn_rcpf(1.0f + __expf(-x)); }
typedef float hg_f32x2 __attribute__((ext_vector_type(2))); typedef __bf16 hg_bf16x2 __attribute__((ext_vector_type(2)));
__device__ __forceinline__ unsigned hg_pk(float lo, float hi) { const hg_f32x2 v = {lo, hi}; const hg_bf16x2 b = __builtin_convertvector(v, hg_bf16x2); return __builtin_bit_cast(unsigned, b); }

#define CGS(x) (ACT_CG ? (x) : silu(x))
constexpr int HG_FB = 8;
template <bool PASSB, int ROLE>
__device__ __forceinline__ void hgrn_unit(LAS unsigned char* lds, const bf16* P, const float* lbl, float* SLOC, float* DTOT, bf16* OFp_, bf16* OBp_, const float* ng, bf16* Yo, int tok0, int c0, int c1, int sg, int h) {
    const int tid = opaque_tid(), lane = tid & 63, wave = __builtin_amdgcn_readfirstlane(tid >> 6);
    const int dir = wave >> 2, wd = wave & 3, sl = lane & 15, g = lane >> 4; constexpr int role = ROLE;
    const int ch = (wd & 1) * 64 + lane;
    const int zoff = (dir ? C_CFB : C_CFF) + h * 128, v0 = C_CI + h * 128 + wd * 32;
    const float lb = lbl[dir * HGD + h * 128 + ch];
    LAS unsigned char* const od = lds + dir * OPS_DIR;
    const int nch = c1 - c0;
    const size_t ubase = (size_t)((sg * HGH + h) * 2 + dir);
    f32x4 S[8][2];
    if (PASSB) {
        const f32x4* sp = (const f32x4*)SLOC + ubase * HG_FRAG + (size_t)wd * 1024 + lane;
#pragma unroll
        for (int ct = 0; ct < 8; ++ct)
#pragma unroll
            for (int vt = 0; vt < 2; ++vt) S[ct][vt] = sp[(ct * 2 + vt) * 64];
    } else {
#pragma unroll
        for (int ct = 0; ct < 8; ++ct)
#pragma unroll
            for (int vt = 0; vt < 2; ++vt) S[ct][vt] = (f32x4){0.f, 0.f, 0.f, 0.f};
    }
    float dtot = 1.0f;
    unsigned short zr[16], qr[16], vr[2][4], vc[2][4];
    constexpr bool needq = PASSB && role == 0, needz = PASSB || role == 1;
    const unsigned vo_z = (unsigned)(zoff + ch) * 2u, vo_q = (unsigned)(C_CQ + h * 128 + ch) * 2u, vo_v = (unsigned)((dir ? 12 - 4 * g : 4 * g) * (DINP * 2) + (v0 + sl) * 2);
#define HG_CB(i) ((const char*)P + (size_t)(tok0 + ((dir ? (c1 - 1 - (i)) : (c0 + (i))) << 4)) * (DINP * 2))
#define HG_TOK(i, s) (tok0 + ((dir ? (c1 - 1 - (i)) : (c0 + (i))) << 4) + (dir ? 15 - (s) : (s)))
#define HG_LOAD_PREP(i) { const char* cb_ = HG_CB(i); _Pragma("unroll") for (int s = 0; s < 16; ++s) { const char* rp_ = cb_ + (size_t)(dir ? 15 - s : s) * (DINP * 2); if (needz) zr[s] = *(const GAS unsigned short*)(rp_ + vo_z); if (needq) qr[s] = *(const GAS unsigned short*)(rp_ + vo_q); } }
#define HG_LOAD_V(i) { const char* cb_ = HG_CB(i); _Pragma("unroll") for (int j = 0; j < 4; ++j) { const char* rp_ = cb_ + (size_t)(dir ? 3 - j : j) * (DINP * 2); vr[0][j] = *(const GAS unsigned short*)(rp_ + vo_v); vr[1][j] = *(const GAS unsigned short*)(rp_ + vo_v + 32); } }
    HG_LOAD_PREP(0)
    HG_LOAD_V(0)
    for (int i = 0; i < nch; ++i) {
        LAS unsigned char* const ob = od + (i & 1) * OPS_BUF;
        if (role == 0) {
            if (PASSB) { float E = 1.0f;
#pragma unroll
                for (int s = 0; s < 16; ++s) { const float f = ACT_HG ? 1.0f - bf2f(zr[s]) : lb + (1.0f - lb) * hg_sig(bf2f(zr[s])); E *= fmaxf(f, 1e-30f);
                    const float x = bf2f(qr[s]); const float qv = ACT_HG ? x : x * hg_sig(x);
                    *(LAS unsigned short*)(ob + OPS_Q + s * HG_QP + 2 * ch) = (unsigned short)hg_pk(qv * E, 0.f); } }
        } else { float E = 1.0f; float kin[16];
#pragma unroll
            for (int s = 0; s < 16; ++s) { const float kz = ACT_HG ? bf2f(zr[s]) : 1.0f - (lb + (1.0f - lb) * hg_sig(bf2f(zr[s]))); E *= fmaxf(1.0f - kz, 1e-30f);
                kin[s] = kz * __builtin_amdgcn_rcpf(fmaxf(E, 1e-37f));
                if (PASSB) *(LAS unsigned short*)(ob + OPS_K + s * HG_QP + 2 * ch) = (unsigned short)hg_pk(kin[s], 0.f); }
            v4u w0, w1;
            w0.x = hg_pk(kin[0] * E, kin[1] * E); w0.y = hg_pk(kin[2] * E, kin[3] * E); w0.z = hg_pk(kin[4] * E, kin[5] * E); w0.w = hg_pk(kin[6] * E, kin[7] * E);
            w1.x = hg_pk(kin[8] * E, kin[9] * E); w1.y = hg_pk(kin[10] * E, kin[11] * E); w1.z = hg_pk(kin[12] * E, kin[13] * E); w1.w = hg_pk(kin[14] * E, kin[15] * E);
            *(LAS v4u*)(ob + OPS_KT + ch * 32) = w0; *(LAS v4u*)(ob + OPS_KT + ch * 32 + 16) = w1;
            *(LAS float*)(ob + OPS_D + ch * 4) = E; dtot *= E; }
#pragma unroll
        for (int vt = 0; vt < 2; ++vt)
#pragma unroll
            for (int j = 0; j < 4; ++j) vc[vt][j] = vr[vt][j];
        if (i + 1 < nch) { HG_LOAD_PREP(i + 1) HG_LOAD_V(i + 1) }
        asm volatile("s_waitcnt lgkmcnt(0)" ::: "memory"); __builtin_amdgcn_s_barrier(); asm volatile("" ::: "memory");
        s16x4 vf[2];
#pragma unroll
        for (int vt = 0; vt < 2; ++vt) { v2u t; t.x = (unsigned)vc[vt][0] | ((unsigned)vc[vt][1] << 16); t.y = (unsigned)vc[vt][2] | ((unsigned)vc[vt][3] << 16); vf[vt] = __builtin_bit_cast(s16x4, t); }
        if (PASSB) {
            v4u qp[4], kp[4];
#pragma unroll
            for (int ks = 0; ks < 4; ++ks) {
                const v2u qa = *(const LAS v2u*)(ob + OPS_Q + sl * HG_QP + (32 * ks + 4 * g) * 2), qb = *(const LAS v2u*)(ob + OPS_Q + sl * HG_QP + (32 * ks + 16 + 4 * g) * 2);
                const v2u ka = *(const LAS v2u*)(ob + OPS_K + sl * HG_QP + (32 * ks + 4 * g) * 2), kb = *(const LAS v2u*)(ob + OPS_K + sl * HG_QP + (32 * ks + 16 + 4 * g) * 2);
                qp[ks] = (v4u){qa.x, qa.y, qb.x, qb.y}; kp[ks] = (v4u){ka.x, ka.y, kb.x, kb.y}; }
            f32x4 at = (f32x4){0.f, 0.f, 0.f, 0.f};
#pragma unroll
            for (int ks = 0; ks < 4; ++ks) at = __builtin_amdgcn_mfma_f32_16x16x32_bf16(__builtin_bit_cast(s16x8, kp[ks]), __builtin_bit_cast(s16x8, qp[ks]), at, 0, 0, 0);
            v2u atp; atp.x = hg_pk((4 * g + 0 <= sl) ? at[0] : 0.f, (4 * g + 1 <= sl) ? at[1] : 0.f); atp.y = hg_pk((4 * g + 2 <= sl) ? at[2] : 0.f, (4 * g + 3 <= sl) ? at[3] : 0.f);
            const s16x4 atf = __builtin_bit_cast(s16x4, atp);
            f32x4 o[2];
#pragma unroll
            for (int vt = 0; vt < 2; ++vt) { o[vt] = (f32x4){0.f, 0.f, 0.f, 0.f};
#pragma unroll
                for (int ks = 0; ks < 4; ++ks) { const f32x4 a0 = S[2 * ks][vt], a1 = S[2 * ks + 1][vt];
                    const v4u sa = (v4u){hg_pk(a0[0], a0[1]), hg_pk(a0[2], a0[3]), hg_pk(a1[0], a1[1]), hg_pk(a1[2], a1[3])};
                    o[vt] = __builtin_amdgcn_mfma_f32_16x16x32_bf16(__builtin_bit_cast(s16x8, sa), __builtin_bit_cast(s16x8, qp[ks]), o[vt], 0, 0, 0); }
                o[vt] = __builtin_amdgcn_mfma_f32_16x16x16bf16_1k(vf[vt], atf, o[vt], 0, 0, 0); }
            bf16* orow = (dir ? OBp_ : OFp_) + (size_t)HG_TOK(i, sl) * HGD + h * 128 + wd * 32 + 4 * g;
            *(GAS v2u*)orow = (v2u){hg_pk(o[0][0], o[0][1]), hg_pk(o[0][2], o[0][3])}; *(GAS v2u*)(orow + 16) = (v2u){hg_pk(o[1][0], o[1][1]), hg_pk(o[1][2], o[1][3])};
        }
#pragma unroll
        for (int ct = 0; ct < 8; ++ct) {
            const f32x4 d4 = *(const LAS f32x4*)(ob + OPS_D + (16 * ct + 4 * g) * 4);
            const s16x4 kt = __builtin_bit_cast(s16x4, *(const LAS v2u*)(ob + OPS_KT + (16 * ct + sl) * 32 + 8 * g));
#pragma unroll
            for (int vt = 0; vt < 2; ++vt) S[ct][vt] = __builtin_amdgcn_mfma_f32_16x16x16bf16_1k(kt, vf[vt], S[ct][vt] * d4, 0, 0, 0);
        }
    }
    if (!PASSB) {
        f32x4* sp = (f32x4*)SLOC + ubase * HG_FRAG + (size_t)wd * 1024 + lane;
#pragma unroll
        for (int ct = 0; ct < 8; ++ct)
#pragma unroll
            for (int vt = 0; vt < 2; ++vt) sp[(ct * 2 + vt) * 64] = S[ct][vt];
        if (role == 1) DTOT[ubase * 128 + ch] = dtot;
    }
    asm volatile("s_waitcnt vmcnt(0) lgkmcnt(0)" ::: "memory"); __builtin_amdgcn_s_barrier(); asm volatile("" ::: "memory");
    if (PASSB) {
        const int ntok = (c1 - c0) * 16, sub = lane >> 5, i4 = (lane & 31) * 4;
        const f32x4 gg = *(const GAS f32x4*)(ng + h * 128 + i4);
        for (int tt0 = wave * 2 + sub; tt0 < ntok; tt0 += 16 * HG_FB) {
            v2u aw[HG_FB], bw[HG_FB], cgw[HG_FB];
#pragma unroll
            for (int u = 0; u < HG_FB; ++u) { const int t = tok0 + c0 * 16 + min(tt0 + 16 * u, ntok - 1); const size_t off = (size_t)t * HGD + h * 128 + i4;
                aw[u] = *(const GAS v2u*)(OFp_ + off); bw[u] = *(const GAS v2u*)(OBp_ + off); cgw[u] = *(const GAS v2u*)(P + (size_t)t * DINP + C_CG + h * 128 + i4); }
#pragma unroll
            for (int u = 0; u < HG_FB; ++u) { const int tt = tt0 + 16 * u, t = tok0 + c0 * 16 + tt;
                const f32x4 o = (f32x4){bflo(aw[u].x) + bflo(bw[u].x), bfhi(aw[u].x) + bfhi(bw[u].x), bflo(aw[u].y) + bflo(bw[u].y), bfhi(aw[u].y) + bfhi(bw[u].y)};
                float s = (o.x * o.x + o.y * o.y) + (o.z * o.z + o.w * o.w);
                s += __shfl_xor(s, 1); s += __shfl_xor(s, 2); s += __shfl_xor(s, 4); s += __shfl_xor(s, 8); s += __shfl_xor(s, 16);
                const float rs = 1.0f / sqrtf(s * (1.f / 128.f) + EPS);
                v2u w; w.x = pk2(o.x * rs * gg.x * CGS(bflo(cgw[u].x)), o.y * rs * gg.y * CGS(bfhi(cgw[u].x))); w.y = pk2(o.z * rs * gg.z * CGS(bflo(cgw[u].y)), o.w * rs * gg.w * CGS(bfhi(cgw[u].y)));
                if (tt < ntok) *(GAS v2u*)(Yo + (size_t)t * D + CONVD + NAD + h * 128 + i4) = w; }
        }
    }
#undef HG_TOK
#undef HG_LOAD_PREP
#undef HG_CB
#undef HG_LOAD_V
}
constexpr int SA_KT = 0, SA_D = 128 * 64, SA_BUF = SA_D + 512, SA_DIR = 2 * SA_BUF;
template <int ROLE>
__device__ __forceinline__ void hgrn_state_unit(LAS unsigned char* lds, const bf16* P, float* SLOC, float* DTOT, int tok0, int c0, int c1, int sg, int h) {
    const int tid = opaque_tid(), lane = tid & 63, wave = __builtin_amdgcn_readfirstlane(tid >> 6);
    const int dir = wave >> 2, wd = wave & 3, sl = lane & 15, g = lane >> 4; constexpr int role = ROLE;
    const int ch = (wd & 1) * 64 + lane;
    const int zoff = (dir ? C_CFB : C_CFF) + h * 128, v0 = C_CI + h * 128 + wd * 32;
    LAS unsigned char* const od = lds + dir * SA_DIR;
    const int ntok = (c1 - c0) * 16, nC = (ntok + 31) >> 5, tokS = tok0 + c0 * 16, tokE = tok0 + c1 * 16;
    const size_t ubase = (size_t)((sg * HGH + h) * 2 + dir);
    f32x4 S[8][2];
#pragma unroll
    for (int ct = 0; ct < 8; ++ct)
#pragma unroll
        for (int vt = 0; vt < 2; ++vt) S[ct][vt] = (f32x4){0.f, 0.f, 0.f, 0.f};
    float dtot = 1.0f;
    unsigned short zr[32]; unsigned vr[2][8], vc[2][8];
#define SA_TOK(p) (dir ? (tokE - 1 - (p)) : (tokS + (p)))
    constexpr size_t ROWB = (size_t)DINP * 2;
    const unsigned vo_z = (unsigned)(zoff + ch) * 2u, vo_vf = (unsigned)((dir ? 24 - 8 * g : 8 * g) * (DINP * 2) + (v0 + sl) * 2), vo_vh = (unsigned)((dir ? 24 - 8 * (g & 1) : 8 * (g & 1)) * (DINP * 2) + (v0 + sl) * 2);
#define SA_LOAD(j) { const char* cb_ = (const char*)P + (size_t)(dir ? tokE - 32 - 32 * (j) : tokS + 32 * (j)) * ROWB;     \
        if (role == 1) { _Pragma("unroll") for (int s = 0; s < 32; ++s) zr[s] = *(const GAS unsigned short*)(cb_ + (size_t)(dir ? 31 - s : s) * ROWB + vo_z); }     \
        const unsigned vo_v_ = (32 * (j) + 32 > ntok) ? vo_vh : vo_vf; \
        _Pragma("unroll") for (int e = 0; e < 8; ++e) { const char* rp_ = cb_ + (size_t)(dir ? 7 - e : e) * ROWB; vr[0][e] = (unsigned)*(const GAS unsigned short*)(rp_ + vo_v_); vr[1][e] = (unsigned)*(const GAS unsigned short*)(rp_ + vo_v_ + 32); } }
    SA_LOAD(0)
    for (int j = 0; j < nC; ++j) {
        LAS unsigned char* const ob = od + (j & 1) * SA_BUF;
        if (role == 1) { float R = 1.0f; float kpp[32];
            const bool hl_ = 32 * j + 32 > ntok;
#pragma unroll
            for (int s = 31; s >= 0; --s) { const float kz = (s >= 16 && hl_) ? 0.f : bf2f(zr[s]); kpp[s] = kz * R; R *= fmaxf(1.0f - kz, 1e-30f); }
#pragma unroll
            for (int q4 = 0; q4 < 4; ++q4) { v4u w; w.x = hg_pk(kpp[8 * q4 + 0], kpp[8 * q4 + 1]); w.y = hg_pk(kpp[8 * q4 + 2], kpp[8 * q4 + 3]); w.z = hg_pk(kpp[8 * q4 + 4], kpp[8 * q4 + 5]); w.w = hg_pk(kpp[8 * q4 + 6], kpp[8 * q4 + 7]);
                *(LAS v4u*)(ob + SA_KT + ch * 64 + q4 * 16) = w; }
            *(LAS float*)(ob + SA_D + ch * 4) = R; dtot *= R; }
#pragma unroll
        for (int vt = 0; vt < 2; ++vt)
#pragma unroll
            for (int e = 0; e < 8; ++e) vc[vt][e] = vr[vt][e];
        if (j + 1 < nC) { SA_LOAD(j + 1) }
        asm volatile("s_waitcnt lgkmcnt(0)" ::: "memory"); __builtin_amdgcn_s_barrier(); asm volatile("" ::: "memory");
        s16x8 vf[2];
#pragma unroll
        for (int vt = 0; vt < 2; ++vt) { v4u t; t.x = vc[vt][0] | (vc[vt][1] << 16); t.y = vc[vt][2] | (vc[vt][3] << 16); t.z = vc[vt][4] | (vc[vt][5] << 16); t.w = vc[vt][6] | (vc[vt][7] << 16);
            vf[vt] = __builtin_bit_cast(s16x8, t); }
#pragma unroll
        for (int ct = 0; ct < 8; ++ct) {
            const f32x4 d4 = *(const LAS f32x4*)(ob + SA_D + (16 * ct + 4 * g) * 4);
            const s16x8 kt = __builtin_bit_cast(s16x8, *(const LAS v4u*)(ob + SA_KT + (16 * ct + sl) * 64 + g * 16));
#pragma unroll
            for (int vt = 0; vt < 2; ++vt) S[ct][vt] = __builtin_amdgcn_mfma_f32_16x16x32_bf16(kt, vf[vt], S[ct][vt] * d4, 0, 0, 0);
        }
    }
    f32x4* sp = (f32x4*)SLOC + ubase * HG_FRAG + (size_t)wd * 1024 + lane;
#pragma unroll
    for (int ct = 0; ct < 8; ++ct)
#pragma unroll
        for (int vt = 0; vt < 2; ++vt) sp[(ct * 2 + vt) * 64] = S[ct][vt];
    if (role == 1) DTOT[ubase * 128 + ch] = dtot;
    asm volatile("s_waitcnt vmcnt(0) lgkmcnt(0)" ::: "memory"); __builtin_amdgcn_s_barrier(); asm volatile("" ::: "memory");
#undef SA_TOK
#undef SA_LOAD
}
__device__ __forceinline__ void hg_seg_range(int sg, int nseq, int L, int& tok0, int& c0, int& c1) {
    const int nss = HG_NSEG / nseq, sq = sg / nss, si = sg - sq * nss, n = L / 16;
    tok0 = sq * L; c0 = (si * n) / nss; c1 = ((si + 1) * n) / nss;
}
__device__ __forceinline__ void hgrn_scan_phase(float* SLOC, const float* DTOT, int nseq) {
    const int tid = opaque_tid(); const int gt = opaque_bid() * (NWAVES * 64) + tid, NT = opaque_G() * NWAVES * 64;
    const int nss = HG_NSEG / nseq;
    for (int e = gt; e < HGH * 2 * (int)HG_FRAG; e += NT) {
        const int hd = e >> 12, f = e & 4095, h = hd >> 1, dir = hd & 1, ct = (f >> 7) & 7, g = (f & 63) >> 4;
        for (int sq = 0; sq < nseq; ++sq) {
            f32x4 S = (f32x4){0.f, 0.f, 0.f, 0.f};
            for (int j0 = 0; j0 < nss; j0 += 21) {
                f32x4 tmp[21], d[21];
#pragma unroll
                for (int k = 0; k < 21; ++k) if (j0 + k < nss) { const int j = dir ? (nss - 1 - (j0 + k)) : (j0 + k); const size_t ub = (size_t)(((sq * nss + j) * HGH + h) * 2 + dir);
                    tmp[k] = *((const GAS f32x4*)SLOC + ub * HG_FRAG + f); d[k] = *(const GAS f32x4*)(DTOT + ub * 128 + 16 * ct + 4 * g); }
#pragma unroll
                for (int k = 0; k < 21; ++k) if (j0 + k < nss) { const int j = dir ? (nss - 1 - (j0 + k)) : (j0 + k); const size_t ub = (size_t)(((sq * nss + j) * HGH + h) * 2 + dir);
                    *((GAS f32x4*)SLOC + ub * HG_FRAG + f) = S; S = d[k] * S + tmp[k]; }
            }
        }
    }
}

constexpr int RPB_LDS_OFF = 65536;
__device__ __forceinline__ void attn_unit(const LAS float* rpbL, const bf16* P, const bf16* VT, const float* RSg, bf16* Y, int tok0, int rows, int r, int jb, int h, int lane) {
    const int sl = lane & 15, g = lane >> 4;
    const int rs = min(max(r - 4, 0), rows - 8), ks0 = min(max(16 * jb - 8, 0), 32);
    const size_t qtok = (size_t)(tok0 + r * 64 + 16 * jb + sl);
    const s16x8 qf0 = __builtin_bit_cast(s16x8, *(const GAS v4u*)(P + qtok * DINP + C_NQ + h * 64 + 8 * g)), qf1 = __builtin_bit_cast(s16x8, *(const GAS v4u*)(P + qtok * DINP + C_NQ + h * 64 + 32 + 8 * g));
    float sc[8][8];
    const bf16* kbase = P + (size_t)(tok0 + rs * 64 + ks0 + 8 * (sl >> 2) + (sl & 3)) * DINP + C_NK + h * 64 + 8 * g;
    v4u kr[8][2][2];
#pragma unroll
    for (int i = 0; i < 8; ++i)
#pragma unroll
        for (int hf = 0; hf < 2; ++hf) { const bf16* kp = kbase + (size_t)(i * 64 + 4 * hf) * DINP; kr[i][hf][0] = *(const GAS v4u*)kp; kr[i][hf][1] = *(const GAS v4u*)(kp + 32); }
    __builtin_amdgcn_sched_barrier(0);
#pragma unroll
    for (int i = 0; i < 8; ++i)
#pragma unroll
        for (int hf = 0; hf < 2; ++hf) {
            f32x4 a = (f32x4){0.f, 0.f, 0.f, 0.f};
            a = __builtin_amdgcn_mfma_f32_16x16x32_bf16(__builtin_bit_cast(s16x8, kr[i][hf][0]), qf0, a, 0, 0, 0); a = __builtin_amdgcn_mfma_f32_16x16x32_bf16(__builtin_bit_cast(s16x8, kr[i][hf][1]), qf1, a, 0, 0, 0);
            sc[i][4 * hf + 0] = a[0]; sc[i][4 * hf + 1] = a[1]; sc[i][4 * hf + 2] = a[2]; sc[i][4 * hf + 3] = a[3]; }
    __builtin_amdgcn_sched_barrier(0);
    const int c = 16 * jb + sl, cs = min(max(c - 8, 0), 48);
    const LAS float* bb = rpbL + h * (15 * 31) + (rs - r + 7) * 31;
    int dco[8]; bool okv[8];
#pragma unroll
    for (int e = 0; e < 8; ++e) { const int kc = ks0 + 8 * g + e; okv[e] = (kc >= cs) && (kc < cs + 16); dco[e] = min(max(kc - c + 15, 0), 30); }
    float mx = -1e30f;
#pragma unroll
    for (int i = 0; i < 8; ++i)
#pragma unroll
        for (int e = 0; e < 8; ++e) { const float bv = bb[i * 31 + dco[e]];
            const float s = okv[e] ? sc[i][e] * (ACT_Q8 ? 1.0f : 0.125f) + bv : -1e30f;
            sc[i][e] = s; mx = fmaxf(mx, s); }
    mx = fmaxf(mx, __shfl_xor(mx, 16)); mx = fmaxf(mx, __shfl_xor(mx, 32));
    float sum = 0.f;
#pragma unroll
    for (int i = 0; i < 8; ++i)
#pragma unroll
        for (int e = 0; e < 8; ++e) { const float pv = __expf(sc[i][e] - mx); sc[i][e] = pv; sum += pv; }
    sum += __shfl_xor(sum, 16); sum += __shfl_xor(sum, 32);
    f32x4 o[4];
#pragma unroll
    for (int dt = 0; dt < 4; ++dt) o[dt] = (f32x4){0.f, 0.f, 0.f, 0.f};
    const bf16* vbase = VT + (size_t)(h * 64 + sl) * GT + tok0 + rs * 64 + ks0 + 8 * g;
#pragma unroll
    for (int i = 0; i < 8; ++i) {
        const v4u pw = (v4u){hg_pk(sc[i][0], sc[i][1]), hg_pk(sc[i][2], sc[i][3]), hg_pk(sc[i][4], sc[i][5]), hg_pk(sc[i][6], sc[i][7])};
#pragma unroll
        for (int dt = 0; dt < 4; ++dt) { const s16x8 vf = __builtin_bit_cast(s16x8, *(const GAS v4u*)(vbase + (size_t)(16 * dt) * GT + i * 64));
            o[dt] = __builtin_amdgcn_mfma_f32_16x16x32_bf16(vf, __builtin_bit_cast(s16x8, pw), o[dt], 0, 0, 0); } }
    const float inv = 1.0f / sum;
    bf16* yp = Y + qtok * D + CONVD + h * 64 + 4 * g;
#pragma unroll
    for (int dt = 0; dt < 4; ++dt) { v2u w; w.x = hg_pk(o[dt][0] * inv, o[dt][1] * inv); w.y = hg_pk(o[dt][2] * inv, o[dt][3] * inv); *(GAS v2u*)(yp + 16 * dt) = w; }
}

__device__ __forceinline__ void panel_rs_table(LAS float* rsl, const float* part, float* rsg, int pm) {
    const int tid = opaque_tid(), row = tid >> 1, half = tid & 1;
    const GAS float* p1 = (const GAS float*)part + (size_t)(half * 16) * GT + pm * 256 + row;
    float v[16];
#pragma unroll
    for (int k = 0; k < 16; ++k) v[k] = p1[(size_t)k * GT];
    float s = (((v[0] + v[1]) + (v[2] + v[3])) + ((v[4] + v[5]) + (v[6] + v[7]))) + (((v[8] + v[9]) + (v[10] + v[11])) + ((v[12] + v[13]) + (v[14] + v[15])));
    s += __shfl_xor(s, 1);
    const float rs = 1.0f / sqrtf(s * (1.0f / D) + EPS);
    if (half == 0) { rsl[row] = rs; if (rsg) rsg[pm * 256 + row] = rs; }
    __syncthreads();
}
constexpr int AT_KOFF = 0, AT_VOFF = 65536, AT_BIAS = 133120, AT_MRG = AT_BIAS + 2048, AT_MRG_JB = 2560;
static_assert(AT_MRG + 4 * AT_MRG_JB <= LDS_BYTES, "attention scratch fits above the ring");
constexpr int AT_BAND = 16;
__device__ __forceinline__ void attn_band(LAS unsigned char* lds, const bf16* P, const bf16* VT, const float* rpb_h, bf16* Y, int tok0, int rows, int r0, int h) {
    const int tid = opaque_tid(), lane = tid & 63, wave = __builtin_amdgcn_readfirstlane(tid >> 6), sl = lane & 15, g = lane >> 4, jb = wave & 3, half = wave >> 2;
    for (int i = tid; i < 15 * 31; i += NWAVES * 64) ((LAS float*)(lds + AT_BIAS))[i] = rpb_h[i] * 1.4426950408889634f;
    const int lk = tid >> 3, lc = tid & 7, lswk = lk * 128 + ((lc ^ (((lk >> 3) & 3) | ((lk & 2) << 1))) * 16), lswv = lk * 128 + ((lc ^ ((lk >> 1) & 7)) * 16);
    const bf16* const kcol = P + (size_t)(tok0 + lk) * DINP + C_NK + h * 64 + lc * 8;
    const bf16* const vrow = VT + (size_t)(h * 64 + lk) * GT + tok0 + lc * 8;
    {
        const int rs0 = min(max(r0 - 4, 0), rows - 8);
        v4u kq[8], vq[8];
#pragma unroll
        for (int i = 0; i < 8; ++i) { kq[i] = *(const GAS v4u*)(kcol + (size_t)((rs0 + i) * 64) * DINP); vq[i] = *(const GAS v4u*)(vrow + (rs0 + i) * 64); }
#pragma unroll
        for (int i = 0; i < 8; ++i) { const int slot = (rs0 + i) & 7; *(LAS v4u*)(lds + AT_KOFF + slot * 8192 + lswk) = kq[i]; *(LAS v4u*)(lds + AT_VOFF + slot * 8192 + lswv) = vq[i]; }
    }
    asm volatile("s_waitcnt lgkmcnt(0)" ::: "memory"); __builtin_amdgcn_s_barrier(); asm volatile("" ::: "memory");
    const int ks0 = min(max(16 * jb - 8, 0), 32), c = 16 * jb + sl, cs = min(max(c - 8, 0), 48);
    int dco[8]; bool okv[8];
#pragma unroll
    for (int e = 0; e < 8; ++e) { const int kc = ks0 + 8 * g + e; okv[e] = (kc >= cs) && (kc < cs + 16); dco[e] = min(max(kc - c + 15, 0), 30); }
    v4u qn0, qn1;
    { const bf16* qp = P + (size_t)(tok0 + r0 * 64 + c) * DINP + C_NQ + h * 64 + 8 * g; qn0 = *(const GAS v4u*)qp; qn1 = *(const GAS v4u*)(qp + 32); }
    int bcur = 1 << 20; f32x4 bv4[4][2];
    for (int rq = r0; rq < r0 + AT_BAND; ++rq) {
        const int rs = min(max(rq - 4, 0), rows - 8), rsn = min(max(rq - 3, 0), rows - 8);
        const bool adv = (rq + 1 < r0 + AT_BAND) && (rsn != rs);
        v4u kn, vn;
        if (adv) { kn = *(const GAS v4u*)(kcol + (size_t)((rs + 8) * 64) * DINP); vn = *(const GAS v4u*)(vrow + (rs + 8) * 64); }
        const size_t qtok = (size_t)(tok0 + rq * 64 + c);
        const s16x8 qf0 = __builtin_bit_cast(s16x8, qn0), qf1 = __builtin_bit_cast(s16x8, qn1);
        if (rq + 1 < r0 + AT_BAND) { const bf16* qp = P + (qtok + 64) * DINP + C_NQ + h * 64 + 8 * g; qn0 = *(const GAS v4u*)qp; qn1 = *(const GAS v4u*)(qp + 32); }
        if (rs - rq != bcur) { bcur = rs - rq;
            const LAS float* bb = (const LAS float*)(lds + AT_BIAS) + (bcur + 4 * half + 7) * 31;
#pragma unroll
            for (int ii = 0; ii < 4; ++ii)
#pragma unroll
                for (int e = 0; e < 8; ++e) bv4[ii][e >> 2][e & 3] = okv[e] ? bb[ii * 31 + dco[e]] : -1e30f; }
        f32x4 sc4[4][2];
#pragma unroll
        for (int ii = 0; ii < 4; ++ii) { const int slot = (rs + 4 * half + ii) & 7;
#pragma unroll
            for (int hf = 0; hf < 2; ++hf) { const int key = ks0 + 8 * (sl >> 2) + 4 * hf + (sl & 3); const LAS unsigned char* kp = lds + AT_KOFF + slot * 8192 + key * 128;
                const int fk = ((key >> 3) & 3) | ((key & 2) << 1);
                const s16x8 k0 = __builtin_bit_cast(s16x8, *(const LAS v4u*)(kp + ((g ^ fk) * 16))), k1 = __builtin_bit_cast(s16x8, *(const LAS v4u*)(kp + (((4 + g) ^ fk) * 16)));
                f32x4 a = (f32x4){0.f, 0.f, 0.f, 0.f};
                a = __builtin_amdgcn_mfma_f32_16x16x32_bf16(k0, qf0, a, 0, 0, 0); a = __builtin_amdgcn_mfma_f32_16x16x32_bf16(k1, qf1, a, 0, 0, 0);
                sc4[ii][hf] = a + bv4[ii][hf]; } }
        float mx = -1e30f;
#pragma unroll
        for (int ii = 0; ii < 4; ++ii)
#pragma unroll
            for (int hf = 0; hf < 2; ++hf) { mx = fmaxf(fmaxf(mx, sc4[ii][hf][0]), sc4[ii][hf][1]); mx = fmaxf(fmaxf(mx, sc4[ii][hf][2]), sc4[ii][hf][3]); }
        mx = fmaxf(mx, __shfl_xor(mx, 16)); mx = fmaxf(mx, __shfl_xor(mx, 32));
        f32x4 sum4 = (f32x4){0.f, 0.f, 0.f, 0.f};
#pragma unroll
        for (int ii = 0; ii < 4; ++ii)
#pragma unroll
            for (int hf = 0; hf < 2; ++hf) { const f32x4 t = sc4[ii][hf] - mx;
                const f32x4 pv = (f32x4){__builtin_amdgcn_exp2f(t[0]), __builtin_amdgcn_exp2f(t[1]), __builtin_amdgcn_exp2f(t[2]), __builtin_amdgcn_exp2f(t[3])}; sc4[ii][hf] = pv; sum4 += pv; }
        float sum = (sum4[0] + sum4[1]) + (sum4[2] + sum4[3]);
        sum += __shfl_xor(sum, 16); sum += __shfl_xor(sum, 32);
        f32x4 o[4];
#pragma unroll
        for (int dt = 0; dt < 4; ++dt) o[dt] = (f32x4){0.f, 0.f, 0.f, 0.f};
#pragma unroll
        for (int ii = 0; ii < 4; ++ii) { const int slot = (rs + 4 * half + ii) & 7;
            const v4u pw = (v4u){hg_pk(sc4[ii][0][0], sc4[ii][0][1]), hg_pk(sc4[ii][0][2], sc4[ii][0][3]), hg_pk(sc4[ii][1][0], sc4[ii][1][1]), hg_pk(sc4[ii][1][2], sc4[ii][1][3])};
#pragma unroll
            for (int dt = 0; dt < 4; ++dt) { const int d = 16 * dt + sl;
                const s16x8 vf = __builtin_bit_cast(s16x8, *(const LAS v4u*)(lds + AT_VOFF + slot * 8192 + d * 128 + ((((ks0 >> 3) + g) ^ ((d >> 1) & 7)) * 16)));
                o[dt] = __builtin_amdgcn_mfma_f32_16x16x32_bf16(vf, __builtin_bit_cast(s16x8, pw), o[dt], 0, 0, 0); } }
        LAS unsigned char* mg = lds + AT_MRG + jb * AT_MRG_JB;
        if (half == 1) {
            *(LAS v4u*)(mg + lane * 32) = (v4u){hg_pk(o[0][0], o[0][1]), hg_pk(o[0][2], o[0][3]), hg_pk(o[1][0], o[1][1]), hg_pk(o[1][2], o[1][3])};
            *(LAS v4u*)(mg + lane * 32 + 16) = (v4u){hg_pk(o[2][0], o[2][1]), hg_pk(o[2][2], o[2][3]), hg_pk(o[3][0], o[3][1]), hg_pk(o[3][2], o[3][3])};
            *(LAS v2u*)(mg + 2048 + lane * 8) = (v2u){__float_as_uint(mx), __float_as_uint(sum)};
        }
        asm volatile("s_waitcnt lgkmcnt(0)" ::: "memory"); __builtin_amdgcn_s_barrier(); asm volatile("" ::: "memory");
        if (half == 0) {
            const v4u p0 = *(const LAS v4u*)(mg + lane * 32), p1 = *(const LAS v4u*)(mg + lane * 32 + 16); const v2u ml = *(const LAS v2u*)(mg + 2048 + lane * 8);
            const float mx2 = __uint_as_float(ml.x), m = fmaxf(mx, mx2), a = __builtin_amdgcn_exp2f(mx - m), b = __builtin_amdgcn_exp2f(mx2 - m), inv = 1.0f / (a * sum + b * __uint_as_float(ml.y));
            const float ai = a * inv, bi = b * inv;
            bf16* yp = Y + qtok * D + CONVD + h * 64 + 4 * g;
            v2u w;
            w.x = hg_pk(o[0][0] * ai + bflo(p0.x) * bi, o[0][1] * ai + bfhi(p0.x) * bi); w.y = hg_pk(o[0][2] * ai + bflo(p0.y) * bi, o[0][3] * ai + bfhi(p0.y) * bi); *(GAS v2u*)(yp) = w;
            w.x = hg_pk(o[1][0] * ai + bflo(p0.z) * bi, o[1][1] * ai + bfhi(p0.z) * bi); w.y = hg_pk(o[1][2] * ai + bflo(p0.w) * bi, o[1][3] * ai + bfhi(p0.w) * bi); *(GAS v2u*)(yp + 16) = w;
            w.x = hg_pk(o[2][0] * ai + bflo(p1.x) * bi, o[2][1] * ai + bfhi(p1.x) * bi); w.y = hg_pk(o[2][2] * ai + bflo(p1.y) * bi, o[2][3] * ai + bfhi(p1.y) * bi); *(GAS v2u*)(yp + 32) = w;
            w.x = hg_pk(o[3][0] * ai + bflo(p1.z) * bi, o[3][1] * ai + bfhi(p1.z) * bi); w.y = hg_pk(o[3][2] * ai + bflo(p1.w) * bi, o[3][3] * ai + bfhi(p1.w) * bi); *(GAS v2u*)(yp + 48) = w;
        }
        if (adv) { const int slot = rs & 7; *(LAS v4u*)(lds + AT_KOFF + slot * 8192 + lswk) = kn; *(LAS v4u*)(lds + AT_VOFF + slot * 8192 + lswv) = vn; }
        asm volatile("s_waitcnt lgkmcnt(0)" ::: "memory"); __builtin_amdgcn_s_barrier(); asm volatile("" ::: "memory");
    }
}

#ifndef REP_NORM
#define REP_NORM 1
#endif
#ifndef REP_WIN
#define REP_WIN 1
#endif
#ifndef REP_MIX
#define REP_MIX 1
#endif
#ifndef REP_HG
#define REP_HG 1
#endif
#ifndef REP_FIN
#define REP_FIN 1
#endif
#ifndef REP_HGA
#define REP_HGA 1
#endif
#ifndef REP_CONV
#define REP_CONV 1
#endif
#ifndef REP_ATT
#define REP_ATT 1
#endif
#ifndef REP_HGB
#define REP_HGB 1
#endif
#ifndef REP_BR
#define REP_BR 1
#endif
#ifndef REP_FFN1
#define REP_FFN1 1
#endif
struct Args { const float* in[17]; float* out; unsigned char* ws; };
__global__ void __launch_bounds__(NWAVES * 64, 2) fwd_kernel(Args args) {
    extern __shared__ __attribute__((aligned(16))) unsigned char lds[];
    Frame F;
    F.lds = (LAS unsigned char*)lds;
    F.MISC = (volatile LAS unsigned*)(F.lds + MISC_OFF);
    (void)args;
    for (int u = threadIdx.x; u < (LDS_BYTES - LDSCTL_OFF) / 4; u += NWAVES * 64) ((LAS unsigned*)(F.lds + LDSCTL_OFF))[u] = 0u;
    __syncthreads();
    (void)xcd_barrier_post((unsigned*)(arg_ws() + WS_CTL) + CW_BAR, F.MISC + 8);
    { unsigned* xw_ = (unsigned*)(arg_ws() + WS_CTL) + CW_XCC + opaque_bid(); const unsigned xv_ = xb_xcc_id() + 1u; if (opaque_tid() == 0) (void)xb_add(xw_, xv_); }
#define GRID_BAR() do { XcdBarrier bar_; bar_.bar = (unsigned*)(arg_ws() + WS_CTL) + CW_BAR; bar_.x = xb_xcc_id(); bar_.st = F.MISC + 8; xcd_barrier(bar_); } while (0)

    p0_prologue(F);
    x_rows_prepare(F, arg_in(0), (bf16*)(arg_ws() + WS_XB), (float*)(arg_ws() + WS_PART), GT, -1);
    GRID_BAR();
    int pm_own;
    { pg8::StaticOrder S; S.init(GT, D, opaque_G(), opaque_bid()); pg8::Unit u0; S.next(0, u0); pm_own = u0.pm; asm volatile("" : "+s"(pm_own)); }
    {
        const int bid_ = opaque_bid(), G_ = opaque_G(); unsigned* w = (unsigned*)(arg_ws() + WS_CTL); const unsigned mine = xb_xcc_id() + 1u;
        int same = (G_ == 256) ? 1 : 0;
#pragma unroll
        for (int r = 0; r < 4; ++r) { const int cc = (bid_ & 63) + 64 * r; pg8::StaticOrder S; S.init(GT, D, G_, cc); pg8::Unit u0; S.next(0, u0); same &= (u0.pm == pm_own) ? 1 : 0; }
        if (opaque_tid() == 0) {
            unsigned ok = 1u;
#pragma unroll
            for (int r = 0; r < 4; ++r) ok &= (xb_ld(w + CW_XCC + (bid_ & 63) + 64 * r) == mine) ? 1u : 0u;
            if (!same || !ok) (void)xb_add(w + CW_MISM, 1u);
        }
    }

#define MIX ((bf16*)(arg_ws() + WS_H))
#define XB ((bf16*)(arg_ws() + WS_XB))
#define PART(k) ((float*)(arg_ws() + WS_PART) + (size_t)(k) * GT * 32)
#define RSL ((LAS float*)(F.lds + RSL_OFF))
#define PANEL_BAR() do { if (__builtin_amdgcn_readfirstlane((int)F.MISC[104])) panel_barrier(F, pm_own); else GRID_BAR(); } while (0)
#define Y ((bf16*)(arg_ws() + WS_Y))
#define P ((bf16*)(arg_ws() + WS_P))
#define OFp ((bf16*)(arg_ws() + WS_OF))
#define OBp ((bf16*)(arg_ws() + WS_OB))
#define xin ((g < 2) ? arg_in(0) + (size_t)g * GT * D : arg_in(1))
#define X (arg_out() + (size_t)g * GT * D)
#define wl ((const bf16*)(arg_ws() + WS_W + (size_t)l * LW))
    for (int g = 0; g < NG; ++g) {
        const int L = (g < 2) ? 8192 : 16384, nseq = GT / L, rows = L / 64;
        if (g > 0) { const int own_ = __builtin_amdgcn_readfirstlane((int)F.MISC[104]) ? pm_own * 256 + (opaque_bid() >> 6) * 64 : -1;
            x_rows_prepare(F, xin, XB, PART(0), GT, own_); PANEL_BAR(); }
        for (int l = 0; l < DEPTH; ++l) {
            for (int rep_ = 0; rep_ < REP_WIN; ++rep_) {
            { pg8::Gemm gm{XB, wl + LW_IN / 2, GT, DINP, D, D, D}; pg8::StaticOrder S; S.init(GT, DINP, opaque_G(), opaque_bid());
              { pg8::Unit u0; S.next(0, u0); panel_rs_table(RSL, PART(0), nullptr, u0.pm); }
              pg8::EpiP16 E{P, DINP, RSL, (const float*)(arg_ws() + WS_LB) + l * 2 * HGD - C_CFF, (unsigned char*)(arg_ws() + WS_G8), 6144};
              pg8::gemm_phase<pg8::EpiP16, pg8::StaticOrder, true, true>(F.lds + RING_OFF, gm, S, E); }
            { pg8::Gemm gm{wl + LW_IN / 2 + (size_t)DINP * D, XB, NAD, GT, D, D, D}; const int c_ = opaque_bid(); pg8::OneUnit S{c_ >> 6, 8 * (c_ & 7) + ((c_ >> 3) & 7), (c_ >> 6) < 3 ? 1 : 0};
              pg8::EpiVT E{(bf16*)(arg_ws() + WS_VT), GT, RSL};
              pg8::gemm_phase<pg8::EpiVT, pg8::OneUnit, true, true>(F.lds + RING_OFF, gm, S, E); }
            }
            GRID_BAR();
            if (g == 0 && l == 0) { if (opaque_tid() == 0) F.MISC[104] = (xb_ld((unsigned*)(arg_ws() + WS_CTL) + CW_MISM) == 0u) ? 1u : 0u; __syncthreads(); }
            for (int rep_ = 0; rep_ < REP_MIX; ++rep_) {
            for (int ra2_ = 0; ra2_ < REP_ATT; ++ra2_)
            { const int u = opaque_bid(), nb = rows / AT_BAND; if (u < nseq * NAH * nb) { const int bnd = u % nb, hh = (u / nb) % NAH, sq = u / (nb * NAH);
                attn_band(F.lds, P, (const bf16*)(arg_ws() + WS_VT), arg_in(5) + (size_t)(l * NAH + hh) * 15 * 31, Y, sq * L, rows, bnd * AT_BAND, hh); } }
            __syncthreads();
            }
            for (int rep_ = 0; rep_ < REP_HG; ++rep_) {
            for (int ra_ = 0; ra_ < REP_HGA; ++ra_)
            { const int u = opaque_bid(); if (u < HG_NSEG * HGH) { const int sg = u / HGH, hh = u - sg * HGH; int tk0, c0, c1; hg_seg_range(sg, nseq, L, tk0, c0, c1);
                { const int wv_ = __builtin_amdgcn_readfirstlane(opaque_tid() >> 6);
                  if ((((wv_ & 3) >> 1) ^ (wv_ >> 2)) == 0) hgrn_state_unit<0>(F.lds + RING_OFF, P, (float*)(arg_ws() + WS_SLOC), (float*)(arg_ws() + WS_DTOT), tk0, c0, c1, sg, hh);
                  else hgrn_state_unit<1>(F.lds + RING_OFF, P, (float*)(arg_ws() + WS_SLOC), (float*)(arg_ws() + WS_DTOT), tk0, c0, c1, sg, hh); } } }
            conv_phase(F, P, Y, arg_in(4) + l * 3 * CONVD, L, (unsigned*)(arg_ws() + WS_CTL) + CW_CONV + (g * DEPTH + l) * 32);
            GRID_BAR();
            hgrn_scan_phase((float*)(arg_ws() + WS_SLOC), (const float*)(arg_ws() + WS_DTOT), nseq);
            GRID_BAR();
            for (int rb_ = 0; rb_ < REP_HGB; ++rb_)
            { const int u = opaque_bid(); if (u < HG_NSEG * HGH) { const int sg = u / HGH, hh = u - sg * HGH; int tk0, c0, c1; hg_seg_range(sg, nseq, L, tk0, c0, c1);
                { const int wv_ = __builtin_amdgcn_readfirstlane(opaque_tid() >> 6);
                  if ((((wv_ & 3) >> 1) ^ (wv_ >> 2)) == 0) hgrn_unit<true, 0>(F.lds + RING_OFF, P, (const float*)(arg_ws() + WS_LB) + l * 2 * HGD, (float*)(arg_ws() + WS_SLOC), (float*)(arg_ws() + WS_DTOT), OFp, OBp, arg_in(7) + l * HGD, Y, tk0, c0, c1, sg, hh);
                  else hgrn_unit<true, 1>(F.lds + RING_OFF, P, (const float*)(arg_ws() + WS_LB) + l * 2 * HGD, (float*)(arg_ws() + WS_SLOC), (float*)(arg_ws() + WS_DTOT), OFp, OBp, arg_in(7) + l * HGD, Y, tk0, c0, c1, sg, hh); } } }
            GRID_BAR();
            }
            for (int rep_ = 0; rep_ < REP_BR; ++rep_)
            { pg8::Gemm gm{Y, wl + LW_BC / 2, GT, D, D, D, D}; pg8::StaticOrder S; S.init(GT, D, opaque_G(), opaque_bid());
              pg8::EpiGate16 E{(const unsigned char*)(arg_ws() + WS_G8), 6144, MIX, D};
              pg8::gemm_phase<pg8::EpiGate16, pg8::StaticOrder, true, true>(F.lds + RING_OFF, gm, S, E); }
            PANEL_BAR();
            { pg8::Gemm gm{MIX, wl + LW_MO / 2, GT, D, D, D, D}; pg8::StaticOrder S; S.init(GT, D, opaque_G(), opaque_bid());
              pg8::EpiResid E{XB, PART(1), D, GT};
              pg8::gemm_phase<pg8::EpiResid, pg8::StaticOrder, true, true>(F.lds + RING_OFF, gm, S, E); }
            PANEL_BAR();
            for (int rep_ = 0; rep_ < REP_FFN1; ++rep_) {
            { pg8::Gemm gm{XB, wl + LW_GU / 2, GT, DGU, D, D, D}; pg8::StaticOrder S; S.init(GT, DGU, opaque_G(), opaque_bid());
              { pg8::Unit u0; S.next(0, u0); panel_rs_table(RSL, PART(1), nullptr, u0.pm); }
              pg8::EpiSwiglu E{P, DINP, RSL};
              pg8::gemm_phase<pg8::EpiSwiglu, pg8::StaticOrder, true, true>(F.lds + RING_OFF, gm, S, E); }
            }
            PANEL_BAR();
            { pg8::Gemm gm{P, wl + LW_D / 2, GT, D, DFF, DINP, DFF}; pg8::StaticOrder S; S.init(GT, D, opaque_G(), opaque_bid());
              pg8::EpiResid E{XB, PART(0), D, GT};
              pg8::gemm_phase<pg8::EpiResid, pg8::StaticOrder, true, true>(F.lds + RING_OFF, gm, S, E); }
            PANEL_BAR();
        }
        if (__builtin_amdgcn_readfirstlane((int)F.MISC[104])) norm_rows_final(F, XB, X, arg_in(16), GT, pm_own * 256 + (opaque_bid() >> 6) * 64);
        else { norm_rows_final(F, XB, X, arg_in(16), GT, -1); GRID_BAR(); }
    }
}

extern "C" void kernel_launch(void* const* d_in, const int* in_sizes, int n_in, void* d_out, int out_size, void* d_ws, size_t ws_size, hipStream_t stream) {
    static int grid = 0;
    if (grid == 0) {
        if (n_in != 17 || out_size != TOK * D || ws_size < WS_END) { fprintf(stderr, "kernel_launch: unexpected shapes (n_in %d, out %d, ws %zu, need %zu); nothing launched\n", n_in, out_size, ws_size, (size_t)WS_END); grid = -1; return; }
        int dev = 0, cus = 0, per_cu = 0;
        if (hipGetDevice(&dev) != hipSuccess || hipDeviceGetAttribute(&cus, hipDeviceAttributeMultiprocessorCount, dev) != hipSuccess) { grid = -1; return; }
        if (hipFuncSetAttribute((const void*)fwd_kernel, hipFuncAttributeMaxDynamicSharedMemorySize, LDS_BYTES) != hipSuccess) { fprintf(stderr, "kernel_launch: hipFuncSetAttribute failed\n"); grid = -1; return; }
        if (hipOccupancyMaxActiveBlocksPerMultiprocessor(&per_cu, (const void*)fwd_kernel, NWAVES * 64, LDS_BYTES) != hipSuccess || per_cu < 1) { fprintf(stderr, "kernel_launch: occupancy query says %d blocks per CU\n", per_cu); per_cu = 1; }
        (void)hipGetLastError();
        grid = cus;
    }
    if (grid < 0) return;
    if (hipMemsetAsync((char*)d_ws + WS_CTL, 0, CTL_ZERO_BYTES, stream) != hipSuccess) return;
    Args a{};
    for (int i = 0; i < 17; ++i) a.in[i] = (const float*)d_in[i];
    a.out = (float*)d_out; a.ws = (unsigned char*)d_ws;
    hipLaunchKernelGGL(fwd_kernel, dim3(grid), dim3(NWAVES * 64), LDS_BYTES, stream, a);
}
```

```cpp
#ifndef ACT_GATE
#define ACT_GATE 1
#endif
#ifndef ACT_CG
#define ACT_CG 1
#endif
#ifndef ACT_HG
#define ACT_HG 1
#endif
#ifndef ACT_Q8
#define ACT_Q8 1
#endif
#include <hip/hip_runtime.h>
#include <cstdio>
#include <cstdint>

namespace pg8 {
#define PG8_LAS __attribute__((address_space(3)))
typedef unsigned short bf16_t;
typedef short bf16x8 __attribute__((ext_vector_type(8)));
typedef float f32x4 __attribute__((ext_vector_type(4)));
typedef unsigned u32x4 __attribute__((ext_vector_type(4)));
constexpr int BM = 256, BK = 64, HALF = 128, HTB = HALF * BK * 2  , STAGE_BYTES = 8 * HTB, NXCD = 8, WGM = 8;

__host__ __device__ __forceinline__ int lds_byte(int r, int c) { const int st = (r >> 4) * 2 + (c >> 5), rr = r & 15, cc = c & 31, ob = rr * 64 + cc * 2; return st * 1024 + (ob ^ (((ob >> 9) & 1) << 5)); }
__host__ __device__ __forceinline__ void stage_rc(int b, int& R, int& C) { const int st = b / 1024, sb = b % 1024, swz = sb ^ (((sb >> 9) & 1) << 5); R = (st >> 1) * 16 + swz / 64; C = (st & 1) * 32 + (swz % 64) / 2; }
__host__ __device__ __forceinline__ int perm32(int rho) { const int n = rho >> 4, i = rho & 15; return 8 * (i >> 2) + 4 * n + (i & 3); }

struct Unit { int pm, pn; };
struct Gemm { const bf16_t* A; const bf16_t* Bt; int M, N, K, lda, ldb; };

struct StaticOrder {
    int nM, nN, nwg, G, c;
    __host__ __device__ __forceinline__ void init(int M, int N, int G_, int c_) { nM = M / BM; nN = N / BM; nwg = nM * nN; G = G_; c = c_; }
    __host__ __device__ __forceinline__ bool next(int i, Unit& u) const {
        const long L = (long)i * G + c; if (L >= nwg) return false;
        int wgid = (int)L; { const int q = nwg / NXCD, r = nwg % NXCD, xcd = wgid % NXCD, off = wgid / NXCD; wgid = (xcd < r ? xcd * (q + 1) : r * (q + 1) + (xcd - r) * q) + off; }
        const int nig = WGM * nN, gid = wgid / nig, fm = gid * WGM, gsz = (nM - fm) < WGM ? (nM - fm) : WGM;
        u.pm = fm + ((wgid % nig) % gsz); u.pn = (wgid % nig) / gsz; return true;
    }
    __device__ __forceinline__ void a_ready(const Unit&) const {}
    __device__ __forceinline__ void done(const Unit&) const {}
};

typedef float cvt_f32x2 __attribute__((ext_vector_type(2))); typedef __bf16 cvt_bf16x2 __attribute__((ext_vector_type(2)));
__device__ __forceinline__ unsigned cvt_pk_bf16(float lo, float hi) { const cvt_f32x2 v = {lo, hi}; const cvt_bf16x2 b = __builtin_convertvector(v, cvt_bf16x2); return __builtin_bit_cast(unsigned, b); }
__device__ __forceinline__ float bflo(unsigned w) { return __uint_as_float(w << 16); }
__device__ __forceinline__ float bfhi(unsigned w) { return __uint_as_float(w & 0xffff0000u); }
__device__ __forceinline__ float sigmoidf_(float x) { return __builtin_amdgcn_rcpf(1.0f + __expf(-x)); }
__device__ __forceinline__ float siluf_(float x) { return x * __builtin_amdgcn_rcpf(1.0f + __expf(-x)); }
__device__ __forceinline__ f32x4 rsig2_(f32x4 t) { f32x4 d = (f32x4){__builtin_amdgcn_exp2f(t[0]), __builtin_amdgcn_exp2f(t[1]), __builtin_amdgcn_exp2f(t[2]), __builtin_amdgcn_exp2f(t[3])} + 1.0f;
    return (f32x4){__builtin_amdgcn_rcpf(d[0]), __builtin_amdgcn_rcpf(d[1]), __builtin_amdgcn_rcpf(d[2]), __builtin_amdgcn_rcpf(d[3])}; }

template <bool SCALE, bool ACTS> struct EpiP {
    static constexpr bool PERM = true, AFTER_DRAIN = false, IDEMPOTENT = true; static constexpr bool HOOKS = false; static constexpr int HOOK_T0 = -1, HOOK_T1 = -1;
    bf16_t* O; int ldc; const PG8_LAS float* rsl; const float* lbc;
    template <int MODE> __device__ __forceinline__ void rows(const f32x4 (&acc)[2][2][4][2], const Unit& u, int wr, int wc, int fr, int fq) const {
        const int rl0 = wr * 64 + fr, row0 = u.pm * BM + rl0, col0 = u.pn * BM + wc * 32 + 8 * fq;
        f32x4 om[2][2];
        if (MODE == 3) {
#pragma unroll
            for (int bj = 0; bj < 2; ++bj)
#pragma unroll
                for (int n = 0; n < 2; ++n) om[bj][n] = 1.0f - *(const f32x4*)(lbc + col0 + bj * HALF + 4 * n);
        }
#pragma unroll
        for (int ai = 0; ai < 2; ++ai)
#pragma unroll
            for (int m = 0; m < 4; ++m) { bf16_t* rowp = O + (size_t)(row0 + ai * HALF + m * 16) * ldc + col0;
                float rs = 1.0f; if (SCALE) rs = rsl[rl0 + ai * HALF + m * 16];
#pragma unroll
                for (int bj = 0; bj < 2; ++bj) { f32x4 v[2] = {acc[ai][bj][m][0], acc[ai][bj][m][1]};
#pragma unroll
                    for (int n = 0; n < 2; ++n) { if (SCALE) v[n] = v[n] * rs;
#pragma unroll
                        for (int e = 0; e < 4; ++e) { const float x = v[n][e];
                            if (MODE == 1) v[n][e] = x * sigmoidf_(x);
                            if (MODE == 2) v[n][e] = sigmoidf_(x);
                            if (MODE == 3) v[n][e] = om[bj][n][e] * sigmoidf_(-x);
                            if (MODE == 4) v[n][e] = x * (0.125f * 1.4426950408889634f);     } }
                    u32x4 w; w.x = cvt_pk_bf16(v[0][0], v[0][1]); w.y = cvt_pk_bf16(v[0][2], v[0][3]); w.z = cvt_pk_bf16(v[1][0], v[1][1]); w.w = cvt_pk_bf16(v[1][2], v[1][3]);
                    *(u32x4*)(rowp + bj * HALF) = w; } }
    }
    __device__ __forceinline__ void operator()(const f32x4 (&acc)[2][2][4][2], const Unit& u, int wr, int wc, int fr, int fq) const {
        if (!ACTS) { rows<0>(acc, u, wr, wc, fr, fq); return; }
        const int pn = u.pn;
        if (ACT_GATE && pn >= 27) rows<2>(acc, u, wr, wc, fr, fq);
        else if ((ACT_CG && pn >= 24 && pn < 27) || (ACT_HG && pn >= 12 && pn < 15)) rows<1>(acc, u, wr, wc, fr, fq);
        else if (ACT_HG && pn >= 15 && pn < 21) rows<3>(acc, u, wr, wc, fr, fq);
        else if (ACT_Q8 && pn >= 6 && pn < 9) rows<4>(acc, u, wr, wc, fr, fq);
        else rows<0>(acc, u, wr, wc, fr, fq);
    }
};
struct EpiVT {
    static constexpr bool PERM = true, AFTER_DRAIN = false, IDEMPOTENT = true; static constexpr bool HOOKS = false; static constexpr int HOOK_T0 = -1, HOOK_T1 = -1;
    bf16_t* O; int ldc; const PG8_LAS float* rsl;
    __device__ __forceinline__ void operator()(const f32x4 (&acc)[2][2][4][2], const Unit& u, int wr, int wc, int fr, int fq) const {
        const int row0 = u.pm * BM + wr * 64 + fr, cl0 = wc * 32 + 8 * fq, col0 = u.pn * BM + cl0;
        f32x4 cs[2][2];
#pragma unroll
        for (int bj = 0; bj < 2; ++bj)
#pragma unroll
            for (int n = 0; n < 2; ++n) cs[bj][n] = *(const PG8_LAS f32x4*)(rsl + cl0 + bj * HALF + 4 * n);
#pragma unroll
        for (int ai = 0; ai < 2; ++ai)
#pragma unroll
            for (int m = 0; m < 4; ++m) { bf16_t* rowp = O + (size_t)(row0 + ai * HALF + m * 16) * ldc + col0;
#pragma unroll
                for (int bj = 0; bj < 2; ++bj) { const f32x4 v0 = acc[ai][bj][m][0] * cs[bj][0], v1 = acc[ai][bj][m][1] * cs[bj][1];
                    u32x4 w; w.x = cvt_pk_bf16(v0[0], v0[1]); w.y = cvt_pk_bf16(v0[2], v0[3]); w.z = cvt_pk_bf16(v1[0], v1[1]); w.w = cvt_pk_bf16(v1[2], v1[3]);
                    *(u32x4*)(rowp + bj * HALF) = w; } }
    }
};
struct OneUnit {
    int pm, pn, have;
    __device__ __forceinline__ bool next(int i, Unit& u) const { if (i != 0 || !have) return false; u.pm = pm; u.pn = pn; return true; }
    __device__ __forceinline__ void a_ready(const Unit&) const {}
    __device__ __forceinline__ void done(const Unit&) const {}
};
#define GSIG(x) (ACT_GATE ? (x) : sigmoidf_(x))
struct EpiGate {
    static constexpr bool PERM = true, AFTER_DRAIN = false, IDEMPOTENT = false; static constexpr bool HOOKS = false; static constexpr int HOOK_T0 = -1, HOOK_T1 = -1;
    const bf16_t* G; int ldg; bf16_t* MIX; int ldm; int first;
    __device__ __forceinline__ void operator()(const f32x4 (&acc)[2][2][4][2], const Unit& u, int wr, int wc, int fr, int fq) const {
        const int row0 = u.pm * BM + wr * 64 + fr, col0 = u.pn * BM + wc * 32 + 8 * fq;
#pragma unroll
        for (int ai = 0; ai < 2; ++ai)
#pragma unroll
            for (int m = 0; m < 4; ++m) { const size_t row = (size_t)(row0 + ai * HALF + m * 16);
#pragma unroll
                for (int bj = 0; bj < 2; ++bj) { const f32x4 v0 = acc[ai][bj][m][0], v1 = acc[ai][bj][m][1];
                    const u32x4 gw = *(const u32x4*)(G + row * ldg + col0 + bj * HALF);
                    bf16_t* mp = MIX + row * ldm + col0 + bj * HALF;
                    u32x4 pw = (u32x4){0u, 0u, 0u, 0u}; if (!first) pw = *(const u32x4*)mp;
                    u32x4 w;
                    w.x = cvt_pk_bf16(bflo(pw.x) + GSIG(bflo(gw.x)) * v0[0], bfhi(pw.x) + GSIG(bfhi(gw.x)) * v0[1]);
                    w.y = cvt_pk_bf16(bflo(pw.y) + GSIG(bflo(gw.y)) * v0[2], bfhi(pw.y) + GSIG(bfhi(gw.y)) * v0[3]);
                    w.z = cvt_pk_bf16(bflo(pw.z) + GSIG(bflo(gw.z)) * v1[0], bfhi(pw.z) + GSIG(bfhi(gw.z)) * v1[1]);
                    w.w = cvt_pk_bf16(bflo(pw.w) + GSIG(bflo(gw.w)) * v1[2], bfhi(pw.w) + GSIG(bfhi(gw.w)) * v1[3]);
                    *(u32x4*)mp = w; } }
    }
};
struct EpiGate3 {
    static constexpr bool PERM = true, AFTER_DRAIN = false, IDEMPOTENT = true, HOOKS = true; static constexpr int HOOK_T0 = 8, HOOK_T1 = 20;
    const bf16_t* G; int ldg; bf16_t* MIX; int ldm;
    __device__ __forceinline__ void hook(f32x4 (&acc)[2][2][4][2], const Unit& u, int wr, int wc, int fr, int fq, int which) const {
        int fr_ = fr, fq_ = fq; asm volatile("" : "+v"(fr_), "+v"(fq_));
        const int row0 = u.pm * BM + wr * 64 + fr_, col0 = u.pn * BM + wc * 32 + 8 * fq_; const bf16_t* gn = G + which * 2048; const bf16_t* gd = gn + 2048;
#pragma unroll
        for (int ai = 0; ai < 2; ++ai)
#pragma unroll
            for (int m = 0; m < 4; ++m) { const size_t off = (size_t)(row0 + ai * HALF + m * 16) * ldg + col0;
#pragma unroll
                for (int bj = 0; bj < 2; ++bj) { const u32x4 nw = *(const u32x4*)(gn + off + bj * HALF), dw = *(const u32x4*)(gd + off + bj * HALF);
#define PG8_RATIO(n_, d_) ((n_) * __builtin_amdgcn_rcpf(fmaxf((d_), 9.5367431640625e-7f)))
                    acc[ai][bj][m][0][0] *= PG8_RATIO(bflo(nw.x), bflo(dw.x)); acc[ai][bj][m][0][1] *= PG8_RATIO(bfhi(nw.x), bfhi(dw.x));
                    acc[ai][bj][m][0][2] *= PG8_RATIO(bflo(nw.y), bflo(dw.y)); acc[ai][bj][m][0][3] *= PG8_RATIO(bfhi(nw.y), bfhi(dw.y));
                    acc[ai][bj][m][1][0] *= PG8_RATIO(bflo(nw.z), bflo(dw.z)); acc[ai][bj][m][1][1] *= PG8_RATIO(bfhi(nw.z), bfhi(dw.z));
                    acc[ai][bj][m][1][2] *= PG8_RATIO(bflo(nw.w), bflo(dw.w)); acc[ai][bj][m][1][3] *= PG8_RATIO(bfhi(nw.w), bfhi(dw.w));
#undef PG8_RATIO
                }
                if (m == 3) asm volatile("" ::: "memory"); }
    }
    __device__ __forceinline__ void operator()(const f32x4 (&acc)[2][2][4][2], const Unit& u, int wr, int wc, int fr, int fq) const {
        const int row0 = u.pm * BM + wr * 64 + fr, col0 = u.pn * BM + wc * 32 + 8 * fq;
#pragma unroll
        for (int ai = 0; ai < 2; ++ai)
#pragma unroll
            for (int m = 0; m < 4; ++m) { const size_t row = (size_t)(row0 + ai * HALF + m * 16);
#pragma unroll
                for (int bj = 0; bj < 2; ++bj) { const f32x4 v0 = acc[ai][bj][m][0], v1 = acc[ai][bj][m][1];
                    const u32x4 gw = *(const u32x4*)(G + 4096 + row * ldg + col0 + bj * HALF);
                    u32x4 w;
                    w.x = cvt_pk_bf16(fmaxf(bflo(gw.x), 9.5367431640625e-7f) * v0[0], fmaxf(bfhi(gw.x), 9.5367431640625e-7f) * v0[1]); w.y = cvt_pk_bf16(fmaxf(bflo(gw.y), 9.5367431640625e-7f) * v0[2], fmaxf(bfhi(gw.y), 9.5367431640625e-7f) * v0[3]);
                    w.z = cvt_pk_bf16(fmaxf(bflo(gw.z), 9.5367431640625e-7f) * v1[0], fmaxf(bfhi(gw.z), 9.5367431640625e-7f) * v1[1]); w.w = cvt_pk_bf16(fmaxf(bflo(gw.w), 9.5367431640625e-7f) * v1[2], fmaxf(bfhi(gw.w), 9.5367431640625e-7f) * v1[3]);
                    *(u32x4*)(MIX + row * ldm + col0 + bj * HALF) = w; } }
    }
};
__device__ __forceinline__ unsigned pack4_u8(float a, float b, float c, float d) {
    unsigned r = 0u; r = __builtin_amdgcn_cvt_pk_u8_f32(a, 0, r); r = __builtin_amdgcn_cvt_pk_u8_f32(b, 1, r); r = __builtin_amdgcn_cvt_pk_u8_f32(c, 2, r); r = __builtin_amdgcn_cvt_pk_u8_f32(d, 3, r); return r; }
__device__ __forceinline__ float ub0(unsigned w) { return (float)(w & 0xffu); }
__device__ __forceinline__ float ub1(unsigned w) { return (float)((w >> 8) & 0xffu); }
__device__ __forceinline__ float ub2(unsigned w) { return (float)((w >> 16) & 0xffu); }
__device__ __forceinline__ float ub3(unsigned w) { return (float)(w >> 24); }
struct EpiP16 {
    static constexpr int PERM = 2; static constexpr bool AFTER_DRAIN = false, IDEMPOTENT = true, HOOKS = false; static constexpr int HOOK_T0 = -1, HOOK_T1 = -1;
    bf16_t* O; int ldc; const PG8_LAS float* rsl; const float* lbc; unsigned char* G8; int ldg8;
    template <int MODE> __device__ __forceinline__ void rows(const f32x4 (&acc)[2][2][4][2], const Unit& u, int wr, int wc, int fr, int fq) const {
        const int rl0 = wr * 64 + fr, row0 = u.pm * BM + rl0, col0 = u.pn * BM + wc * 64 + 16 * fq;
        f32x4 om[2][2];
        if (MODE == 3) {
#pragma unroll
            for (int bj = 0; bj < 2; ++bj)
#pragma unroll
                for (int n = 0; n < 2; ++n) om[bj][n] = 1.0f - *(const f32x4*)(lbc + col0 + 8 * bj + 4 * n);
        }
#pragma unroll
        for (int ai = 0; ai < 2; ++ai)
#pragma unroll
            for (int m = 0; m < 4; ++m) { const int row = row0 + ai * HALF + m * 16; const float rs0 = rsl[rl0 + ai * HALF + m * 16];
                const float rs = (MODE == 1 || MODE == 2) ? rs0 * -1.4426950408889634f : (MODE == 3) ? rs0 * 1.4426950408889634f : (MODE == 4) ? rs0 * (0.125f * 1.4426950408889634f) : rs0;
                f32x4 v[2][2];
#pragma unroll
                for (int bj = 0; bj < 2; ++bj)
#pragma unroll
                    for (int n = 0; n < 2; ++n) { const f32x4 t = acc[ai][bj][m][n] * rs;
                        if (MODE == 0 || MODE == 4) v[bj][n] = t;
                        if (MODE == 1) v[bj][n] = (acc[ai][bj][m][n] * rs0) * rsig2_(t);
                        if (MODE == 3) v[bj][n] = om[bj][n] * rsig2_(t);
                        if (MODE == 2) { const f32x4 d = (f32x4){__builtin_amdgcn_exp2f(t[0]), __builtin_amdgcn_exp2f(t[1]), __builtin_amdgcn_exp2f(t[2]), __builtin_amdgcn_exp2f(t[3])} * (1.0f / 255.0f) + (1.0f / 255.0f);
#pragma unroll
                            for (int e = 0; e < 4; ++e) v[bj][n][e] = fmaxf(__builtin_rintf(__builtin_amdgcn_rcpf(d[e])), 1.0f); } }
                if (MODE == 2) { u32x4 w; w.x = pack4_u8(v[0][0][0], v[0][0][1], v[0][0][2], v[0][0][3]); w.y = pack4_u8(v[0][1][0], v[0][1][1], v[0][1][2], v[0][1][3]);
                    w.z = pack4_u8(v[1][0][0], v[1][0][1], v[1][0][2], v[1][0][3]); w.w = pack4_u8(v[1][1][0], v[1][1][1], v[1][1][2], v[1][1][3]);
                    *(u32x4*)(G8 + (size_t)row * ldg8 + (col0 - 6912)) = w; }
                else { bf16_t* rowp = O + (size_t)row * ldc + col0;
#pragma unroll
                    for (int bj = 0; bj < 2; ++bj) { u32x4 w; w.x = cvt_pk_bf16(v[bj][0][0], v[bj][0][1]); w.y = cvt_pk_bf16(v[bj][0][2], v[bj][0][3]); w.z = cvt_pk_bf16(v[bj][1][0], v[bj][1][1]); w.w = cvt_pk_bf16(v[bj][1][2], v[bj][1][3]);
                        *(u32x4*)(rowp + 8 * bj) = w; } } }
    }
    __device__ __forceinline__ void operator()(const f32x4 (&acc)[2][2][4][2], const Unit& u, int wr, int wc, int fr, int fq) const {
        const int pn = u.pn;
        if (pn >= 27) rows<2>(acc, u, wr, wc, fr, fq);
        else if (pn >= 24 || (pn >= 12 && pn < 15)) rows<1>(acc, u, wr, wc, fr, fq);
        else if (pn >= 15 && pn < 21) rows<3>(acc, u, wr, wc, fr, fq);
        else if (pn >= 6 && pn < 9) rows<4>(acc, u, wr, wc, fr, fq);
        else rows<0>(acc, u, wr, wc, fr, fq);
    }
};
struct EpiGate16 {
    static constexpr int PERM = 2; static constexpr bool AFTER_DRAIN = false, IDEMPOTENT = true, HOOKS = true; static constexpr int HOOK_T0 = 8, HOOK_T1 = 20;
    const unsigned char* G8; int ldg8; bf16_t* MIX; int ldm;
    __device__ __forceinline__ void hook(f32x4 (&acc)[2][2][4][2], const Unit& u, int wr, int wc, int fr, int fq, int which) const {
        int fr_ = fr, fq_ = fq; asm volatile("" : "+v"(fr_), "+v"(fq_));
        const int row0 = u.pm * BM + wr * 64 + fr_, col0 = u.pn * BM + wc * 64 + 16 * fq_; const unsigned char* gn = G8 + which * 2048; const unsigned char* gd = gn + 2048;
#pragma unroll
        for (int ai = 0; ai < 2; ++ai)
#pragma unroll
            for (int m = 0; m < 4; ++m) { const size_t off = (size_t)(row0 + ai * HALF + m * 16) * ldg8 + col0;
                const u32x4 nw = *(const u32x4*)(gn + off), dw = *(const u32x4*)(gd + off);
#define PG8_R8(n_, d_) ((n_) * __builtin_amdgcn_rcpf(d_))
                acc[ai][0][m][0][0] *= PG8_R8(ub0(nw.x), ub0(dw.x)); acc[ai][0][m][0][1] *= PG8_R8(ub1(nw.x), ub1(dw.x)); acc[ai][0][m][0][2] *= PG8_R8(ub2(nw.x), ub2(dw.x)); acc[ai][0][m][0][3] *= PG8_R8(ub3(nw.x), ub3(dw.x));
                acc[ai][0][m][1][0] *= PG8_R8(ub0(nw.y), ub0(dw.y)); acc[ai][0][m][1][1] *= PG8_R8(ub1(nw.y), ub1(dw.y)); acc[ai][0][m][1][2] *= PG8_R8(ub2(nw.y), ub2(dw.y)); acc[ai][0][m][1][3] *= PG8_R8(ub3(nw.y), ub3(dw.y));
                acc[ai][1][m][0][0] *= PG8_R8(ub0(nw.z), ub0(dw.z)); acc[ai][1][m][0][1] *= PG8_R8(ub1(nw.z), ub1(dw.z)); acc[ai][1][m][0][2] *= PG8_R8(ub2(nw.z), ub2(dw.z)); acc[ai][1][m][0][3] *= PG8_R8(ub3(nw.z), ub3(dw.z));
                acc[ai][1][m][1][0] *= PG8_R8(ub0(nw.w), ub0(dw.w)); acc[ai][1][m][1][1] *= PG8_R8(ub1(nw.w), ub1(dw.w)); acc[ai][1][m][1][2] *= PG8_R8(ub2(nw.w), ub2(dw.w)); acc[ai][1][m][1][3] *= PG8_R8(ub3(nw.w), ub3(dw.w));
#undef PG8_R8
                if (m == 3) asm volatile("" ::: "memory"); }
    }
    __device__ __forceinline__ void operator()(const f32x4 (&acc)[2][2][4][2], const Unit& u, int wr, int wc, int fr, int fq) const {
        const int row0 = u.pm * BM + wr * 64 + fr, col0 = u.pn * BM + wc * 64 + 16 * fq; const float k = 1.0f / 255.0f;
#pragma unroll
        for (int ai = 0; ai < 2; ++ai)
#pragma unroll
            for (int m = 0; m < 4; ++m) { const size_t row = (size_t)(row0 + ai * HALF + m * 16);
                const u32x4 gw = *(const u32x4*)(G8 + 4096 + row * ldg8 + col0);
                const f32x4 a0 = acc[ai][0][m][0], a1 = acc[ai][0][m][1], b0 = acc[ai][1][m][0], b1 = acc[ai][1][m][1];
                u32x4 w0, w1;
                w0.x = cvt_pk_bf16(ub0(gw.x) * k * a0[0], ub1(gw.x) * k * a0[1]); w0.y = cvt_pk_bf16(ub2(gw.x) * k * a0[2], ub3(gw.x) * k * a0[3]);
                w0.z = cvt_pk_bf16(ub0(gw.y) * k * a1[0], ub1(gw.y) * k * a1[1]); w0.w = cvt_pk_bf16(ub2(gw.y) * k * a1[2], ub3(gw.y) * k * a1[3]);
                w1.x = cvt_pk_bf16(ub0(gw.z) * k * b0[0], ub1(gw.z) * k * b0[1]); w1.y = cvt_pk_bf16(ub2(gw.z) * k * b0[2], ub3(gw.z) * k * b0[3]);
                w1.z = cvt_pk_bf16(ub0(gw.w) * k * b1[0], ub1(gw.w) * k * b1[1]); w1.w = cvt_pk_bf16(ub2(gw.w) * k * b1[2], ub3(gw.w) * k * b1[3]);
                bf16_t* mp = MIX + row * ldm + col0; *(u32x4*)mp = w0; *(u32x4*)(mp + 8) = w1; }
    }
};
struct EpiResid {
    static constexpr int PERM = 2; static constexpr bool AFTER_DRAIN = false, IDEMPOTENT = false; static constexpr bool HOOKS = false; static constexpr int HOOK_T0 = -1, HOOK_T1 = -1;
    bf16_t* xb; float* part; int ldc; int partld;
    __device__ __forceinline__ void operator()(const f32x4 (&acc)[2][2][4][2], const Unit& u, int wr, int wc, int fr, int fq) const {
        const int row0 = u.pm * BM + wr * 64 + fr, col0 = u.pn * BM + wc * 64 + 16 * fq;
#pragma unroll
        for (int ai = 0; ai < 2; ++ai)
#pragma unroll
            for (int m = 0; m < 4; ++m) { const int row = row0 + ai * HALF + m * 16; bf16_t* xp = xb + (size_t)row * ldc + col0; float q = 0.f;
#pragma unroll
                for (int bj = 0; bj < 2; ++bj) { const u32x4 b = *(const u32x4*)(xp + bj * 8); const f32x4 a0 = acc[ai][bj][m][0], a1 = acc[ai][bj][m][1];
                    u32x4 w; w.x = cvt_pk_bf16(bflo(b.x) + a0[0], bfhi(b.x) + a0[1]); w.y = cvt_pk_bf16(bflo(b.y) + a0[2], bfhi(b.y) + a0[3]);
                    w.z = cvt_pk_bf16(bflo(b.z) + a1[0], bfhi(b.z) + a1[1]); w.w = cvt_pk_bf16(bflo(b.w) + a1[2], bfhi(b.w) + a1[3]);
                    *(u32x4*)(xp + bj * 8) = w;
                    const float r0 = bflo(w.x), r1 = bfhi(w.x), r2 = bflo(w.y), r3 = bfhi(w.y), r4 = bflo(w.z), r5 = bfhi(w.z), r6 = bflo(w.w), r7 = bfhi(w.w);
                    q += (r0 * r0 + r1 * r1) + (r2 * r2 + r3 * r3) + (r4 * r4 + r5 * r5) + (r6 * r6 + r7 * r7); }
                q += __shfl_xor(q, 16); q += __shfl_xor(q, 32);
                if (fq == 0) part[(size_t)(u.pn * 4 + wc) * partld + row] = q; }
    }
};
struct EpiSwiglu {
    static constexpr bool PERM = true, AFTER_DRAIN = false, IDEMPOTENT = true; static constexpr bool HOOKS = false; static constexpr int HOOK_T0 = -1, HOOK_T1 = -1;
    bf16_t* O; int ldc; const PG8_LAS float* rsl;
    __device__ __forceinline__ void operator()(const f32x4 (&acc)[2][2][4][2], const Unit& u, int wr, int wc, int fr, int fq) const {
        const int rl0 = wr * 64 + fr, row0 = u.pm * BM + rl0, col0 = u.pn * HALF + wc * 32 + 8 * fq;
#pragma unroll
        for (int ai = 0; ai < 2; ++ai)
#pragma unroll
            for (int m = 0; m < 4; ++m) { const int row = row0 + ai * HALF + m * 16; bf16_t* rowp = O + (size_t)row * ldc + col0;
                const float rs = rsl[rl0 + ai * HALF + m * 16], rs2 = rs * -1.4426950408889634f, rsq = rs * rs;
                const f32x4 o0 = (acc[ai][0][m][0] * acc[ai][1][m][0]) * rsq * rsig2_(acc[ai][0][m][0] * rs2), o1 = (acc[ai][0][m][1] * acc[ai][1][m][1]) * rsq * rsig2_(acc[ai][0][m][1] * rs2);
                u32x4 w; w.x = cvt_pk_bf16(o0[0], o0[1]); w.y = cvt_pk_bf16(o0[2], o0[3]); w.z = cvt_pk_bf16(o1[0], o1[1]); w.w = cvt_pk_bf16(o1[2], o1[3]);
                *(u32x4*)rowp = w; }
    }
};

#ifndef PG8_EREP
#define PG8_EREP 1
#endif
#ifndef PG8_KREP
#define PG8_KREP 1
#endif
template <class Epi, class Sched, bool ALIGN_EPI = false, bool SP2 = false>
__device__ __forceinline__ void gemm_phase(PG8_LAS unsigned char* lds, const Gemm g, const Sched& S, const Epi& E) {
    int tid_ = threadIdx.x; asm volatile("" : "+v"(tid_));
    const int tid = tid_, wid = __builtin_amdgcn_readfirstlane(tid >> 6), lane = tid & 63, wr = wid >> 2, wc = wid & 3, fr = lane & 15, fq = lane >> 4;
    const int K = g.K, nt = K / BK;
    unsigned voffA[2], voffB[2], voffB1[2];
#pragma unroll
    for (int i = 0; i < 2; ++i) { int R, C; stage_rc(tid * 16 + i * 8192, R, C);
        if constexpr (Epi::PERM == 2) {
            const int Rg = 64 * (R >> 5) + 16 * ((R & 15) >> 2) + 4 * ((R >> 4) & 1) + (R & 3);
            voffB[i] = (unsigned)(Rg * g.ldb + C) * 2u; voffB1[i] = (unsigned)((Rg + 8) * g.ldb + C) * 2u;
        } else { const int Rb = Epi::PERM ? ((R & ~31) + perm32(R & 31)) : R; voffB[i] = (unsigned)(Rb * g.ldb + C) * 2u; voffB1[i] = voffB[i]; }
        voffA[i] = (unsigned)(R * g.lda + C) * 2u; }
    const size_t kstep = (size_t)(BK * 2);
    const size_t hstepA = (size_t)HALF * g.lda * 2, hstepB = (Epi::PERM == 2) ? 0 : (size_t)HALF * g.ldb * 2;
    const size_t tstepA = 2 * hstepA, tstepB = (size_t)BM * g.ldb * 2;
    const unsigned ldsw = (unsigned)wid * 1024u;
    const int aoff = lds_byte(wr * 64 + fr, fq * 8), boff = lds_byte(wc * 32 + fr, fq * 8);
#define PG8_SA(b, h) (((b) * 2 + (h)) * HTB)
#define PG8_SB(b, h) ((4 + (b) * 2 + (h)) * HTB)
#define PG8_STAGE(bufoff, gbase, voff) do { _Pragma("unroll") for (int _i = 0; _i < 2; ++_i) \
        __builtin_amdgcn_global_load_lds((const unsigned*)((const char*)(gbase) + (voff)[_i]), (PG8_LAS unsigned*)(lds + (bufoff) + ldsw + _i * 8192), 16, 0, 0); } while (0)
#define PG8_LDA(dst, b, h) do { _Pragma("unroll") for (int m = 0; m < 4; ++m) _Pragma("unroll") for (int k = 0; k < 2; ++k) dst[m][k] = *(const PG8_LAS bf16x8*)(lds + PG8_SA(b, h) + aoff + m * 2048 + k * 1024); } while (0)
#define PG8_LDB(dst, b, h) do { _Pragma("unroll") for (int n = 0; n < 2; ++n) _Pragma("unroll") for (int k = 0; k < 2; ++k) dst[n][k] = *(const PG8_LAS bf16x8*)(lds + PG8_SB(b, h) + boff + n * 2048 + k * 1024); } while (0)
#define PG8_MMA(ai, bj, At, Bt) do { __builtin_amdgcn_s_setprio(1); _Pragma("unroll") for (int m = 0; m < 4; ++m) _Pragma("unroll") for (int n = 0; n < 2; ++n) _Pragma("unroll") for (int k = 0; k < 2; ++k) \
        acc[ai][bj][m][n] = __builtin_amdgcn_mfma_f32_16x16x32_bf16(Bt[n][k], At[m][k], acc[ai][bj][m][n], 0, 0, 0); __builtin_amdgcn_s_setprio(0); } while (0)
#define PG8_WAIT_V(n) asm volatile("s_waitcnt vmcnt(" #n ")" ::: "memory")
#define PG8_WAIT_L(n) asm volatile("s_waitcnt lgkmcnt(" #n ")" ::: "memory")
#define PG8_BAR __builtin_amdgcn_s_barrier()
#define PG8_SCHED __builtin_amdgcn_sched_barrier(0)
    Unit cur, nxt; int ui = 0;
    if (!S.next(0, cur)) return;
    f32x4 acc[2][2][4][2];
#pragma unroll
    for (int a = 0; a < 2; ++a)
#pragma unroll
        for (int b = 0; b < 2; ++b)
#pragma unroll
            for (int m = 0; m < 4; ++m)
#pragma unroll
                for (int n = 0; n < 2; ++n) acc[a][b][m][n] = (f32x4){0.f, 0.f, 0.f, 0.f};
    bf16x8 At[4][2], B0[2][2], B1[2][2];
    const char* cA = (const char*)g.A + (size_t)cur.pm * tstepA; const char* cB = (const char*)g.Bt + (size_t)cur.pn * tstepB;
    S.a_ready(cur);
    if constexpr (SP2) {
        PG8_STAGE(PG8_SB(0, 0), cB, voffB); PG8_STAGE(PG8_SB(0, 1), cB + hstepB, voffB1); PG8_STAGE(PG8_SA(0, 0), cA, voffA); PG8_STAGE(PG8_SA(0, 1), cA + hstepA, voffA);
        if (wr == 1) PG8_BAR;
        PG8_WAIT_V(2); PG8_BAR;
        PG8_STAGE(PG8_SB(1, 0), cB + kstep, voffB); PG8_STAGE(PG8_SA(1, 0), cA + kstep, voffA); PG8_STAGE(PG8_SB(1, 1), cB + hstepB + kstep, voffB1);
        PG8_WAIT_V(6); PG8_BAR;
    } else {
        PG8_STAGE(PG8_SB(0, 0), cB, voffB); PG8_STAGE(PG8_SA(0, 0), cA, voffA); PG8_STAGE(PG8_SB(0, 1), cB + hstepB, voffB1); PG8_STAGE(PG8_SA(0, 1), cA + hstepA, voffA);
        if (wr == 1) PG8_BAR;
        PG8_WAIT_V(4); PG8_BAR;
        PG8_STAGE(PG8_SB(1, 0), cB + kstep, voffB); PG8_STAGE(PG8_SA(1, 0), cA + kstep, voffA); PG8_STAGE(PG8_SB(1, 1), cB + hstepB + kstep, voffB1);
        PG8_WAIT_V(6); PG8_BAR;
    }
    for (;;) {
        const bool has_next = S.next(ui + 1, nxt);
        const char* nA = has_next ? (const char*)g.A + (size_t)nxt.pm * tstepA : cA; const char* nB = has_next ? (const char*)g.Bt + (size_t)nxt.pn * tstepB : cB;
        for (int kr = 0; kr < PG8_KREP; ++kr)
        for (int t = 0; t < nt; t += 2) {
            const bool lastp = (t == nt - 2), last = lastp && (kr == PG8_KREP - 1);
            if constexpr (Epi::HOOKS) { if (t == Epi::HOOK_T0 || t == Epi::HOOK_T1) E.hook(acc, cur, wr, wc, fr, fq, t == Epi::HOOK_T0 ? 0 : 1); }
            const char* a1 = cA + (size_t)(t + 1) * kstep;
            const char* a2 = last ? nA : (lastp ? cA : cA + (size_t)(t + 2) * kstep); const char* b2 = last ? nB : (lastp ? cB : cB + (size_t)(t + 2) * kstep);
            const char* a3 = a2 + kstep; const char* b3 = b2 + kstep;
            if (last && has_next) S.a_ready(nxt);
            if constexpr (SP2) {
            PG8_LDB(B0, 0, 0); PG8_LDB(B1, 0, 1); PG8_SCHED; PG8_LDA(At, 0, 0); PG8_STAGE(PG8_SA(1, 1), a1 + hstepA, voffA);
            PG8_WAIT_V(8); PG8_WAIT_L(0); PG8_BAR; PG8_MMA(0, 0, At, B0); PG8_MMA(0, 1, At, B1); PG8_BAR; PG8_SCHED;
            PG8_LDA(At, 0, 1); PG8_STAGE(PG8_SB(0, 0), b2, voffB); PG8_STAGE(PG8_SB(0, 1), b2 + hstepB, voffB1); PG8_STAGE(PG8_SA(0, 0), a2, voffA);
            PG8_WAIT_V(8); PG8_WAIT_L(0); PG8_BAR; PG8_MMA(1, 0, At, B0); PG8_MMA(1, 1, At, B1); PG8_BAR; PG8_SCHED;
            PG8_LDB(B0, 1, 0); PG8_LDB(B1, 1, 1); PG8_SCHED; PG8_LDA(At, 1, 0); PG8_STAGE(PG8_SA(0, 1), a2 + hstepA, voffA);
            PG8_WAIT_V(8); PG8_WAIT_L(0); PG8_BAR; PG8_MMA(0, 0, At, B0); PG8_MMA(0, 1, At, B1); PG8_BAR; PG8_SCHED;
            PG8_LDA(At, 1, 1); PG8_STAGE(PG8_SB(1, 0), b3, voffB); PG8_STAGE(PG8_SB(1, 1), b3 + hstepB, voffB1); PG8_STAGE(PG8_SA(1, 0), a3, voffA);
            PG8_WAIT_V(8); PG8_WAIT_L(0); PG8_BAR; PG8_MMA(1, 0, At, B0); PG8_MMA(1, 1, At, B1); PG8_BAR; PG8_SCHED;
            } else {
            PG8_LDB(B0, 0, 0); PG8_SCHED; PG8_LDA(At, 0, 0); PG8_STAGE(PG8_SA(1, 1), a1 + hstepA, voffA);
            PG8_WAIT_L(8); PG8_BAR; PG8_WAIT_L(0); PG8_MMA(0, 0, At, B0); PG8_BAR; PG8_SCHED;
            PG8_LDB(B1, 0, 1); PG8_STAGE(PG8_SB(0, 0), b2, voffB);
            PG8_BAR; PG8_WAIT_L(0); PG8_MMA(0, 1, At, B1); PG8_BAR;
            PG8_LDA(At, 0, 1); PG8_STAGE(PG8_SA(0, 0), a2, voffA);
            PG8_BAR; PG8_WAIT_L(0); PG8_MMA(1, 0, At, B0); PG8_BAR; PG8_SCHED;
            PG8_STAGE(PG8_SB(0, 1), b2 + hstepB, voffB1);
            PG8_WAIT_V(6); PG8_BAR; PG8_MMA(1, 1, At, B1); PG8_BAR;
            PG8_LDB(B0, 1, 0); PG8_SCHED; PG8_LDA(At, 1, 0); PG8_STAGE(PG8_SA(0, 1), a2 + hstepA, voffA);
            PG8_WAIT_L(8); PG8_BAR; PG8_WAIT_L(0); PG8_MMA(0, 0, At, B0); PG8_BAR; PG8_SCHED;
            PG8_LDB(B1, 1, 1); PG8_STAGE(PG8_SB(1, 0), b3, voffB);
            PG8_BAR; PG8_WAIT_L(0); PG8_MMA(0, 1, At, B1); PG8_BAR;
            PG8_LDA(At, 1, 1); PG8_STAGE(PG8_SA(1, 0), a3, voffA);
            PG8_BAR; PG8_WAIT_L(0); PG8_MMA(1, 0, At, B0); PG8_BAR; PG8_SCHED;
            PG8_STAGE(PG8_SB(1, 1), b3 + hstepB, voffB1);
            PG8_WAIT_V(6); PG8_BAR; PG8_MMA(1, 1, At, B1); PG8_BAR;
            }
        }
        if (PG8_KREP > 1) {
#pragma unroll
            for (int a = 0; a < 2; ++a)
#pragma unroll
                for (int b = 0; b < 2; ++b)
#pragma unroll
                    for (int m = 0; m < 4; ++m)
#pragma unroll
                        for (int n = 0; n < 2; ++n) acc[a][b][m][n] = acc[a][b][m][n] * (1.0f / PG8_KREP); }
        if constexpr (ALIGN_EPI) { if (wr == 0) PG8_BAR; }
        if constexpr (!Epi::AFTER_DRAIN) { E(acc, cur, wr, wc, fr, fq); if (PG8_EREP > 1 && Epi::IDEMPOTENT) { asm volatile("" ::: "memory"); E(acc, cur, wr, wc, fr, fq); } S.done(cur); }
        if (!has_next) break;
#pragma unroll
        for (int a = 0; a < 2; ++a)
#pragma unroll
            for (int b = 0; b < 2; ++b)
#pragma unroll
                for (int m = 0; m < 4; ++m)
#pragma unroll
                    for (int n = 0; n < 2; ++n) acc[a][b][m][n] = (f32x4){0.f, 0.f, 0.f, 0.f};
        cur = nxt; cA = nA; cB = nB; ++ui;
        if constexpr (ALIGN_EPI) { if (wr == 1) PG8_BAR; }
    }
    PG8_WAIT_V(0);
    if constexpr (!ALIGN_EPI) { if (wr == 0) PG8_BAR; }
    PG8_BAR;
    if constexpr (Epi::AFTER_DRAIN) { E.fused(acc, cur, wr, wc, fr, fq, lds, wid, lane); S.done(cur); }
#undef PG8_SA
#undef PG8_SB
#undef PG8_STAGE
#undef PG8_LDA
#undef PG8_LDB
#undef PG8_MMA
#undef PG8_WAIT_V
#undef PG8_WAIT_L
#undef PG8_BAR
#undef PG8_SCHED
}
}

constexpr int D = 2048, DEPTH = 4, DIN = 13824, DFF = 5632, DGU = 2 * DFF;
constexpr int TOK = 49152, GT = 16384, NG = 3;
constexpr int CONVD = 512, NAD = 768, HGD = 768, NAH = 12, HGH = 6;
constexpr int DINP = DIN - NAD;
constexpr int C_AH = 0, C_AB = 512, C_AC = 1024, C_NQ = 1536, C_NK = 2304, C_CQ = 3072, C_CFF = 3840, C_CFB = 4608, C_CI = 5376, C_CG = 6144, C_GA = 6912;
constexpr float EPS = 1e-6f;
constexpr int NWAVES = 8;

constexpr size_t MiB = 1u << 20;
constexpr size_t WS_CTL = 0, CTL_ZERO_BYTES = 1 * MiB;
constexpr size_t WS_LB = 4 * MiB;
constexpr size_t WS_W = 5 * MiB;
constexpr size_t LW_IN = 0, LW_BC = LW_IN + (size_t)DIN * D * 2, LW_BA = LW_BC + (size_t)D * CONVD * 2, LW_BH = LW_BA + (size_t)D * NAD * 2, LW_MO = LW_BH + (size_t)D * HGD * 2,
                 LW_GU = LW_MO + (size_t)D * D * 2, LW_D = LW_GU + (size_t)DGU * D * 2, LW = LW_D + (size_t)D * DFF * 2;
static_assert(LW == 136 * MiB, "per-layer weight bytes");
constexpr size_t WS_H = WS_W + DEPTH * LW;
constexpr size_t WS_Y = WS_H + (size_t)GT * D * 2;
constexpr size_t WS_P = WS_Y + (size_t)GT * D * 2;
constexpr size_t WS_OF = WS_P + (size_t)GT * DIN * 2;
constexpr size_t WS_OB = WS_OF + (size_t)GT * HGD * 4;
constexpr size_t WS_SLOC = WS_OB + (size_t)GT * HGD * 4;
constexpr size_t WS_DTOT = WS_SLOC + (size_t)42 * 6 * 2 * 65536;
constexpr size_t WS_VT = WS_DTOT + 1 * MiB;
constexpr size_t WS_XB = WS_VT + (size_t)NAD * GT * 2;
constexpr size_t WS_PART = WS_XB + (size_t)GT * D * 2;
constexpr size_t WS_RS = WS_PART + (size_t)2 * GT * 32 * 4;
constexpr size_t WS_G8 = WS_RS + 1 * MiB;
constexpr size_t WS_END = WS_G8 + (size_t)GT * 6144;
constexpr int CW_TMO = 0, CW_BAR = 4096;
constexpr int CW_PANEL = 196608, CW_XCC = 200704, CW_MISM = 201216;

constexpr int RING_OFF = 0, RING_BYTES = 131072;
constexpr int LDSCTL_OFF = RING_BYTES, MISC_OFF = LDSCTL_OFF + 320, RSL_OFF = LDSCTL_OFF + 1024;
constexpr int LDS_BYTES = 147456;

#define GAS __attribute__((address_space(1)))
#define LAS __attribute__((address_space(3)))
typedef unsigned short bf16;
typedef unsigned v4u __attribute__((ext_vector_type(4)));
typedef unsigned v2u __attribute__((ext_vector_type(2)));
typedef float f32x4 __attribute__((ext_vector_type(4)));
typedef GAS unsigned gu32;
#define RLX_AGENT __ATOMIC_RELAXED, __HIP_MEMORY_SCOPE_AGENT
#define LDS_WAIT() asm volatile("s_waitcnt lgkmcnt(0)" ::: "memory")
#define VM_WAIT() asm volatile("s_waitcnt vmcnt(0)" ::: "memory")
__device__ __forceinline__ unsigned f2bf(float f) { unsigned u = __builtin_bit_cast(unsigned, f); return (u + 0x7fffu + ((u >> 16) & 1u)) >> 16; }
__device__ __forceinline__ unsigned pk2(float lo, float hi) { return f2bf(lo) | (f2bf(hi) << 16); }
__device__ __forceinline__ float bf2f(bf16 b) { return __uint_as_float(((unsigned)b) << 16); }
__device__ __forceinline__ float bflo(unsigned w) { return __uint_as_float(w << 16); }
__device__ __forceinline__ float bfhi(unsigned w) { return __uint_as_float(w & 0xffff0000u); }
__device__ __forceinline__ float sigm(float x) { return 1.0f / (1.0f + __expf(-x)); }
__device__ __forceinline__ float silu(float x) { return x / (1.0f + __expf(-x)); }

#define XB_TMO      128
#define XB_XCNT(j)  (256  + 64 * (j))
#define XB_XSUB(j)  (1280 + 64 * (j))
#define XB_XGEN(j)  (2304 + 64 * (j))
#define XB_TOP      3328
#define XB_TOPGEN   3392
#define XCD_BAR_WORDS 3456
#define XB_SPIN_CAP (1u << 18)

__device__ __forceinline__ unsigned xb_ld(unsigned* p)              { return __hip_atomic_load(p, __ATOMIC_RELAXED, __HIP_MEMORY_SCOPE_AGENT); }
__device__ __forceinline__ unsigned xb_add(unsigned* p, unsigned v) { return __hip_atomic_fetch_add(p, v, __ATOMIC_RELAXED, __HIP_MEMORY_SCOPE_AGENT); }
__device__ __forceinline__ unsigned xb_xcc_id() { return (unsigned)__builtin_amdgcn_s_getreg((3 << 11) | 20) & 0xFu; }
#define XB_SPIN(cond, bar) do { unsigned _sp = 0; while (cond) { __builtin_amdgcn_s_sleep(1); \
    if ((++_sp & 255u) == 0u) { if (xb_ld(&(bar)[XB_TMO])) break; if (_sp > XB_SPIN_CAP) { atomicAdd(&(bar)[XB_TMO], 1u); break; } } } } while (0)

struct XcdBarrier {
    unsigned* bar; unsigned x;
    volatile LAS unsigned* st;
};

__device__ __forceinline__ XcdBarrier xcd_barrier_post(unsigned* bar, volatile LAS unsigned* st) {
    XcdBarrier b; b.bar = bar; b.x = xb_xcc_id(); b.st = st;
    if (threadIdx.x == 0) (void)xb_add(&bar[XB_XCNT(b.x)], 1u);
    return b;
}
__device__ __forceinline__ void xcd_barrier_complete(unsigned* bar, unsigned x, unsigned& nloc, unsigned& nx) {
    const unsigned G = gridDim.x * gridDim.y * gridDim.z;
    unsigned sum, cnt, mine, sp = 0u;
    for (;;) {
        sum = 0u; cnt = 0u; mine = 0u;
#pragma unroll
        for (unsigned j = 0; j < 16; ++j) { const unsigned c = xb_ld(&bar[XB_XCNT(j)]); sum += c; cnt += (c > 0u) ? 1u : 0u; mine = (j == x) ? c : mine; }
        if (sum == G) break;
        __builtin_amdgcn_s_sleep(1);
        if ((++sp & 255u) == 0u) { if (xb_ld(&bar[XB_TMO])) break; if (sp > XB_SPIN_CAP) { atomicAdd(&bar[XB_TMO], 1u); break; } }
    }
    nloc = mine > 0u ? mine : 1u; nx = cnt > 0u ? cnt : 1u;
}

__device__ __forceinline__ void xcd_barrier(const XcdBarrier& b) {
    asm volatile("s_waitcnt vmcnt(0)" ::: "memory");
    __syncthreads();
    if (threadIdx.x == 0) {
        unsigned* bar = b.bar;
        __builtin_amdgcn_s_waitcnt(0);
        unsigned nloc = b.st[0], nx = b.st[1];
        if (nloc == 0u) { xcd_barrier_complete(bar, b.x, nloc, nx); b.st[0] = nloc; b.st[1] = nx; }
        const unsigned old = xb_add(&bar[XB_XSUB(b.x)], 1u);
        const unsigned gen = old / nloc;
        if (old + 1u == (gen + 1u) * nloc) {
            __builtin_amdgcn_fence(__ATOMIC_RELEASE, "agent");
            asm volatile("s_waitcnt vmcnt(0)" ::: "memory");
            const unsigned og = xb_add(&bar[XB_TOP], 1u);
            const unsigned tg = og / nx;
            if (og + 1u == (tg + 1u) * nx) xb_add(&bar[XB_TOPGEN], 1u);
            else XB_SPIN(xb_ld(&bar[XB_TOPGEN]) == tg, bar);
            __builtin_amdgcn_fence(__ATOMIC_ACQUIRE, "agent");
            xb_add(&bar[XB_XGEN(b.x)], 1u);
            asm volatile("s_waitcnt vmcnt(0)" ::: "memory");
        } else {
            XB_SPIN(xb_ld(&bar[XB_XGEN(b.x)]) == gen, bar);
            __builtin_amdgcn_fence(__ATOMIC_ACQUIRE, "agent");
            asm volatile("s_waitcnt vmcnt(0)" ::: "memory");
        }
    }
    __syncthreads();
}

struct Frame {
    LAS unsigned char* lds;
    volatile LAS unsigned* MISC;
};
#define CAS __attribute__((address_space(4)))
__device__ __forceinline__ const CAS unsigned char* karg_ptr() { const CAS unsigned char* kp = (const CAS unsigned char*)__builtin_amdgcn_kernarg_segment_ptr(); asm volatile("" : "+s"(kp)); return kp; }
__device__ __forceinline__ const float* arg_in(int i) { return *(const float* const CAS*)(karg_ptr() + 8 * i); }
__device__ __forceinline__ float* arg_out() { return *(float* const CAS*)(karg_ptr() + 8 * 17); }
__device__ __forceinline__ unsigned char* arg_ws() { return *(unsigned char* const CAS*)(karg_ptr() + 8 * 18); }
__device__ __forceinline__ int opaque_tid() { int t = threadIdx.x; asm volatile("" : "+v"(t)); return t; }
__device__ __forceinline__ int opaque_bid() { int b = blockIdx.x; asm volatile("" : "+s"(b)); return b; }
__device__ __forceinline__ int opaque_G() { int g = gridDim.x; asm volatile("" : "+s"(g)); return g; }
__device__ __forceinline__ void panel_barrier(Frame& F, int pm) {
    asm volatile("s_waitcnt vmcnt(0)" ::: "memory");
    __syncthreads();
    unsigned* w = (unsigned*)(arg_ws() + WS_CTL);
    if (opaque_tid() == 0) {
        __builtin_amdgcn_s_waitcnt(0);
        unsigned* ctr = w + CW_PANEL + pm * 32;
        const unsigned ep = F.MISC[105] + 1u; F.MISC[105] = ep;
        (void)xb_add(ctr, 1u);
        XB_SPIN(xb_ld(ctr) < 4u * ep, w + CW_BAR);
        __builtin_amdgcn_fence(__ATOMIC_ACQUIRE, "agent");
        asm volatile("s_waitcnt vmcnt(0)" ::: "memory");
    }
    __syncthreads();
}
__device__ __forceinline__ float wave_sum(float v) {
#pragma unroll
    for (int o = 1; o < 64; o <<= 1) v += __shfl_xor(v, o);
    return v;
}

constexpr int P0_PITCH = 68;
template <int MAP>
__device__ __forceinline__ void p0_transpose_item(const float* W, int K, int N, bf16* WT, const float* gk, LAS float* scr, int item, int lane, int dpitch = 0, int koff = 0) {
    if (dpitch == 0) dpitch = K;
    const int nblk = N / 64, kb = item / nblk, nb = item % nblk, k0 = 32 * kb, n0 = 64 * nb;
    const int lr = lane >> 4, ln = (lane & 15) * 4;
#pragma unroll
    for (int i = 0; i < 8; ++i) { const int kk = 4 * i + lr; f32x4 w = *(const GAS f32x4*)(W + (size_t)(k0 + kk) * N + n0 + ln); if (gk) w = w * gk[k0 + kk];
        *(LAS f32x4*)(scr + kk * P0_PITCH + ln) = w; }
    LDS_WAIT(); asm volatile("" ::: "memory");
    const int c = lane & 3;
    const int drow0 = (MAP == 0) ? n0 : (MAP == 3) ? (n0 < 3072 ? n0 : (n0 < 3840 ? n0 + (DINP - 3072) : n0 - NAD)) : ((n0 >> 7) * 256 + (MAP == 2 ? 128 : 0) + (n0 & 127));
#pragma unroll
    for (int j = 0; j < 4; ++j) { const int n = (lane >> 2) + 16 * j; const LAS float* s = scr + (8 * c) * P0_PITCH + n;
        v4u o; o.x = pk2(s[0 * P0_PITCH], s[1 * P0_PITCH]); o.y = pk2(s[2 * P0_PITCH], s[3 * P0_PITCH]); o.z = pk2(s[4 * P0_PITCH], s[5 * P0_PITCH]); o.w = pk2(s[6 * P0_PITCH], s[7 * P0_PITCH]);
        *(GAS v4u*)(WT + (size_t)(drow0 + n) * dpitch + koff + k0 + 8 * c) = o; }
    LDS_WAIT(); asm volatile("" ::: "memory");
}
__device__ __forceinline__ void p0_prologue(Frame& F) {
    const int tid = opaque_tid(), lane = tid & 63, wave = __builtin_amdgcn_readfirstlane(tid >> 6);
    LAS float* scr = (LAS float*)(F.lds + RING_OFF + wave * 16384);
    const int gw = opaque_bid() * NWAVES + wave, NGW = opaque_G() * NWAVES;
    constexpr int I_IN = (D / 32) * (DIN / 64), I_BC = (CONVD / 32) * (D / 64), I_BA = (NAD / 32) * (D / 64), I_BH = (HGD / 32) * (D / 64), I_MO = (D / 32) * (D / 64),
                  I_G = (D / 32) * (DFF / 64), I_D = (DFF / 32) * (D / 64), I_L = I_IN + I_BC + I_BA + I_BH + I_MO + 2 * I_G + I_D;
    for (int it = gw; it < DEPTH * I_L; it += NGW) {
        const int l = it / I_L; int r = it - l * I_L;
        bf16* wl = (bf16*)(arg_ws() + WS_W + (size_t)l * LW);
        if (r < I_IN) { p0_transpose_item<3>(arg_in(3) + (size_t)l * D * DIN, D, DIN, wl + LW_IN / 2, arg_in(2) + l * D, scr, r, lane); continue; } r -= I_IN;
        if (r < I_BC) { p0_transpose_item<0>(arg_in(8) + (size_t)l * CONVD * D, CONVD, D, wl + LW_BC / 2, nullptr, scr, r, lane, D, 0); continue; } r -= I_BC;
        if (r < I_BA) { p0_transpose_item<0>(arg_in(9) + (size_t)l * NAD * D, NAD, D, wl + LW_BC / 2, nullptr, scr, r, lane, D, CONVD); continue; } r -= I_BA;
        if (r < I_BH) { p0_transpose_item<0>(arg_in(10) + (size_t)l * HGD * D, HGD, D, wl + LW_BC / 2, nullptr, scr, r, lane, D, CONVD + NAD); continue; } r -= I_BH;
        if (r < I_MO) { p0_transpose_item<0>(arg_in(11) + (size_t)l * D * D, D, D, wl + LW_MO / 2, nullptr, scr, r, lane); continue; } r -= I_MO;
        if (r < I_G) { p0_transpose_item<1>(arg_in(13) + (size_t)l * D * DFF, D, DFF, wl + LW_GU / 2, arg_in(12) + l * D, scr, r, lane); continue; } r -= I_G;
        if (r < I_G) { p0_transpose_item<2>(arg_in(14) + (size_t)l * D * DFF, D, DFF, wl + LW_GU / 2, arg_in(12) + l * D, scr, r, lane); continue; } r -= I_G;
        p0_transpose_item<0>(arg_in(15) + (size_t)l * DFF * D, DFF, D, wl + LW_D / 2, nullptr, scr, r, lane);
    }
    const int gt = opaque_bid() * (NWAVES * 64) + tid;
    if (gt < 2 * HGD) {
        const float* hl = arg_in(6); float v[DEPTH]; float mx = -3.4e38f;
#pragma unroll
        for (int l = 0; l < DEPTH; ++l) { v[l] = hl[l * 2 * HGD + gt]; mx = fmaxf(mx, v[l]); }
        float s = 0.f;
#pragma unroll
        for (int l = 0; l < DEPTH; ++l) { v[l] = expf(v[l] - mx); s += v[l]; }
        float* LB = (float*)(arg_ws() + WS_LB); float c = 0.f;
#pragma unroll
        for (int l = 0; l < DEPTH; ++l) { const float sm = v[l] / s; c += sm; LB[l * 2 * HGD + gt] = (l == 0) ? 0.f : c - v[0] / s; }
    }
}

__device__ __forceinline__ void x_rows_prepare(Frame& F, const float* x, bf16* o, float* ss, int rows, int own) {
    const int tid = opaque_tid(), lane = tid & 63, wave = __builtin_amdgcn_readfirstlane(tid >> 6);
    const int gw = own >= 0 ? own + wave : opaque_bid() * NWAVES + wave, NGW = own >= 0 ? NWAVES : opaque_G() * NWAVES, mend = own >= 0 ? own + 64 : rows;
    for (int m = gw; m < mend; m += NGW) {
        const GAS f32x4* xr = (const GAS f32x4*)(x + (size_t)m * D) + lane;
        f32x4 v[8]; float s = 0.f;
#pragma unroll
        for (int j = 0; j < 8; ++j) v[j] = xr[64 * j];
        GAS v2u* o8 = (GAS v2u*)(o + (size_t)m * D) + lane;
#pragma unroll
        for (int j = 0; j < 8; ++j) { v2u w; w.x = pk2(v[j].x, v[j].y); w.y = pk2(v[j].z, v[j].w); o8[64 * j] = w;
            const float r0 = bflo(w.x), r1 = bfhi(w.x), r2 = bflo(w.y), r3 = bfhi(w.y); s += (r0 * r0 + r1 * r1) + (r2 * r2 + r3 * r3); }
        s = wave_sum(s);
        if (lane < 32) ss[(size_t)lane * GT + m] = (lane == 0) ? s : 0.f;
    }
}
__device__ __forceinline__ void norm_rows_final(Frame& F, const bf16* xb, float* out, const float* gain, int rows, int own) {
    const int tid = opaque_tid(), lane = tid & 63, wave = __builtin_amdgcn_readfirstlane(tid >> 6);
    const int gw = own >= 0 ? own + wave : opaque_bid() * NWAVES + wave, NGW = own >= 0 ? NWAVES : opaque_G() * NWAVES, mend = own >= 0 ? own + 64 : rows;
    for (int m = gw; m < mend; m += NGW) {
        const GAS v4u* xr = (const GAS v4u*)(xb + (size_t)m * D) + lane; GAS f32x4* orow = (GAS f32x4*)(out + (size_t)m * D); const GAS f32x4* gr = (const GAS f32x4*)gain;
        v4u w[4]; float s = 0.f;
#pragma unroll
        for (int j = 0; j < 4; ++j) { w[j] = xr[64 * j];
            const float r0 = bflo(w[j].x), r1 = bfhi(w[j].x), r2 = bflo(w[j].y), r3 = bfhi(w[j].y), r4 = bflo(w[j].z), r5 = bfhi(w[j].z), r6 = bflo(w[j].w), r7 = bfhi(w[j].w);
            s += (r0 * r0 + r1 * r1) + (r2 * r2 + r3 * r3) + (r4 * r4 + r5 * r5) + (r6 * r6 + r7 * r7); }
        const float rs = 1.0f / sqrtf(wave_sum(s) * (1.f / D) + EPS);
#pragma unroll
        for (int j = 0; j < 4; ++j) { const int c4 = (64 * j + lane) * 2; const f32x4 g0 = gr[c4], g1 = gr[c4 + 1];
            orow[c4] = (f32x4){bflo(w[j].x) * rs * g0.x, bfhi(w[j].x) * rs * g0.y, bflo(w[j].y) * rs * g0.z, bfhi(w[j].y) * rs * g0.w};
            orow[c4 + 1] = (f32x4){bflo(w[j].z) * rs * g1.x, bfhi(w[j].z) * rs * g1.y, bflo(w[j].w) * rs * g1.z, bfhi(w[j].w) * rs * g1.w}; }
    }
}

constexpr int CONV_CH = 16, CW_CONV = 65536;
__device__ __forceinline__ void conv_phase(Frame& F, const bf16* P, bf16* Y, const float* cw, int L, unsigned* ctr) {
    const int tid_ = opaque_tid();
    const int ch = (tid_ & 63) * 8;
    volatile LAS int* slot = (volatile LAS int*)(F.lds + LDSCTL_OFF + 768);
    if (tid_ == 0) slot[0] = (int)__hip_atomic_fetch_add(ctr, 1u, __ATOMIC_RELAXED, __HIP_MEMORY_SCOPE_AGENT);
    __syncthreads();
    int cur = slot[0], par = 0;
    const f32x4 w0a = *(const GAS f32x4*)(cw + ch), w0b = *(const GAS f32x4*)(cw + ch + 4), w1a = *(const GAS f32x4*)(cw + 512 + ch), w1b = *(const GAS f32x4*)(cw + 512 + ch + 4),
                w2a = *(const GAS f32x4*)(cw + 1024 + ch), w2b = *(const GAS f32x4*)(cw + 1024 + ch + 4);
    while (cur < GT / CONV_CH) {
    unsigned nxt = 0u; if (tid_ == 0) nxt = __hip_atomic_fetch_add(ctr, 1u, __ATOMIC_RELAXED, __HIP_MEMORY_SCOPE_AGENT);
#pragma unroll
    for (int i_ = 0; i_ < CONV_CH / 8; ++i_) {
        const int t = cur * CONV_CH + i_ * 8 + (tid_ >> 6), pos = t % L;
        const bf16* row = P + (size_t)t * DINP + ch;
        const v4u z4 = (v4u){0u, 0u, 0u, 0u};
        const v4u h1 = *(const GAS v4u*)(row + C_AH), c1 = *(const GAS v4u*)(row + C_AC), b1 = *(const GAS v4u*)(row + C_AB);
        v4u h0 = z4, c0 = z4, h2 = z4, c2 = z4;
        if (pos > 0) { h0 = *(const GAS v4u*)(row - DINP + C_AH); c0 = *(const GAS v4u*)(row - DINP + C_AC); }
        if (pos < L - 1) { h2 = *(const GAS v4u*)(row + DINP + C_AH); c2 = *(const GAS v4u*)(row + DINP + C_AC); }
        float y[8];
#define CONV1(k, hw0, cw0, hw1, cw1, hw2, cw2, bw, W0, W1, W2, e, HL) { const float u0 = HL(hw0) * HL(cw0), u1 = HL(hw1) * HL(cw1), u2 = HL(hw2) * HL(cw2); y[k] = HL(bw) * (u0 * W0[e] + u1 * W1[e] + u2 * W2[e]); }
        CONV1(0, h0.x, c0.x, h1.x, c1.x, h2.x, c2.x, b1.x, w0a, w1a, w2a, 0, bflo) CONV1(1, h0.x, c0.x, h1.x, c1.x, h2.x, c2.x, b1.x, w0a, w1a, w2a, 1, bfhi)
        CONV1(2, h0.y, c0.y, h1.y, c1.y, h2.y, c2.y, b1.y, w0a, w1a, w2a, 2, bflo) CONV1(3, h0.y, c0.y, h1.y, c1.y, h2.y, c2.y, b1.y, w0a, w1a, w2a, 3, bfhi)
        CONV1(4, h0.z, c0.z, h1.z, c1.z, h2.z, c2.z, b1.z, w0b, w1b, w2b, 0, bflo) CONV1(5, h0.z, c0.z, h1.z, c1.z, h2.z, c2.z, b1.z, w0b, w1b, w2b, 1, bfhi)
        CONV1(6, h0.w, c0.w, h1.w, c1.w, h2.w, c2.w, b1.w, w0b, w1b, w2b, 2, bflo) CONV1(7, h0.w, c0.w, h1.w, c1.w, h2.w, c2.w, b1.w, w0b, w1b, w2b, 3, bfhi)
#undef CONV1
        v4u o; o.x = pk2(y[0], y[1]); o.y = pk2(y[2], y[3]); o.z = pk2(y[4], y[5]); o.w = pk2(y[6], y[7]);
        *(GAS v4u*)(Y + (size_t)t * D + ch) = o;
    }
    if (tid_ == 0) slot[par ^ 1] = (int)nxt;
    __syncthreads();
    par ^= 1; cur = slot[par];
    }
}

typedef short s16x4 __attribute__((ext_vector_type(4)));
typedef short s16x8 __attribute__((ext_vector_type(8)));
constexpr int HG_NSEG = 42;
constexpr int HG_QP = 272;
constexpr int OPS_Q = 0, OPS_K = 16 * HG_QP, OPS_KT = 2 * 16 * HG_QP, OPS_D = OPS_KT + 128 * 32, OPS_BUF = OPS_D + 512, OPS_DIR = 2 * OPS_BUF;
static_assert(2 * OPS_DIR <= RING_BYTES, "HGRN operand images fit the ring region");
constexpr size_t HG_FRAG = 4096;

__device__ __forceinline__ float hg_sig(float x) { return __builtin_amdgcn_rcpf(1.0f + __expf(-x)); }
typedef float hg_f32x2 __attribute__((ext_vector_type(2))); typedef __bf16 hg_bf16x2 __attribute__((ext_vector_type(2)));
__device__ __forceinline__ unsigned hg_pk(float lo, float hi) { const hg_f32x2 v = {lo, hi}; const hg_bf16x2 b = __builtin_convertvector(v, hg_bf16x2); return __builtin_bit_cast(unsigned, b); }

constexpr int P_BYTES = (int)((size_t)GT * DINP * 2);
__device__ __forceinline__ __amdgpu_buffer_rsrc_t p_rsrc(const bf16* P) {
    const unsigned long long pb = (unsigned long long)P;
    const unsigned lo = __builtin_amdgcn_readfirstlane((unsigned)pb), hi = __builtin_amdgcn_readfirstlane((unsigned)(pb >> 32));
    return __builtin_amdgcn_make_buffer_rsrc((void*)(((unsigned long long)hi << 32) | lo), 0, P_BYTES, 0x00020000);
}
#define PB16(srd, vo, so) ((unsigned short)__builtin_amdgcn_raw_buffer_load_b16(srd, vo, so, 0))
#define CGS(x) (ACT_CG ? (x) : silu(x))
constexpr int HG_FB = 8;
template <bool PASSB, int ROLE>
__device__ __forceinline__ void hgrn_unit(LAS unsigned char* lds, const bf16* P, const float* lbl, float* SLOC, float* DTOT, bf16* OFp_, bf16* OBp_, const float* ng, bf16* Yo, int tok0, int c0, int c1, int sg, int h) {
    const int tid = opaque_tid(), lane = tid & 63, wave = __builtin_amdgcn_readfirstlane(tid >> 6);
    const int dir = wave >> 2, wd = wave & 3, sl = lane & 15, g = lane >> 4; constexpr int role = ROLE;
    const int ch = (wd & 1) * 64 + lane;
    const int zoff = (dir ? C_CFB : C_CFF) + h * 128, v0 = C_CI + h * 128 + wd * 32;
    const float lb = lbl[dir * HGD + h * 128 + ch];
    LAS unsigned char* const od = lds + dir * OPS_DIR;
    const int nch = c1 - c0;
    const size_t ubase = (size_t)((sg * HGH + h) * 2 + dir);
    f32x4 S[8][2];
    if (PASSB) {
        const f32x4* sp = (const f32x4*)SLOC + ubase * HG_FRAG + (size_t)wd * 1024 + lane;
#pragma unroll
        for (int ct = 0; ct < 8; ++ct)
#pragma unroll
            for (int vt = 0; vt < 2; ++vt) S[ct][vt] = sp[(ct * 2 + vt) * 64];
    } else {
#pragma unroll
        for (int ct = 0; ct < 8; ++ct)
#pragma unroll
            for (int vt = 0; vt < 2; ++vt) S[ct][vt] = (f32x4){0.f, 0.f, 0.f, 0.f};
    }
    float dtot = 1.0f;
    unsigned short zr[16], qr[16], vr[2][4], vc[2][4];
    constexpr bool needq = PASSB && role == 0, needz = PASSB || role == 1;
    const unsigned vo_z = (unsigned)(zoff + ch) * 2u, vo_q = (unsigned)(C_CQ + h * 128 + ch) * 2u, vo_v = (unsigned)((dir ? 12 - 4 * g : 4 * g) * (DINP * 2) + (v0 + sl) * 2);
    const __amdgpu_buffer_rsrc_t srd = p_rsrc(P);
#define HG_CB(i) ((unsigned)(tok0 + ((dir ? (c1 - 1 - (i)) : (c0 + (i))) << 4)) * (unsigned)(DINP * 2))
#define HG_TOK(i, s) (tok0 + ((dir ? (c1 - 1 - (i)) : (c0 + (i))) << 4) + (dir ? 15 - (s) : (s)))
#define HG_LOAD_PREP(i) { const unsigned cb_ = HG_CB(i); _Pragma("unroll") for (int s = 0; s < 16; ++s) { const unsigned so_ = cb_ + (unsigned)(dir ? 15 - s : s) * (unsigned)(DINP * 2); if (needz) zr[s] = PB16(srd, vo_z, so_); if (needq) qr[s] = PB16(srd, vo_q, so_); } }
#define HG_LOAD_V(i) { const unsigned cb_ = HG_CB(i); _Pragma("unroll") for (int j = 0; j < 4; ++j) { const unsigned so_ = cb_ + (unsigned)(dir ? 3 - j : j) * (unsigned)(DINP * 2); vr[0][j] = PB16(srd, vo_v, so_); vr[1][j] = PB16(srd, vo_v + 32u, so_); } }
    HG_LOAD_PREP(0)
    HG_LOAD_V(0)
    for (int i = 0; i < nch; ++i) {
        LAS unsigned char* const ob = od + (i & 1) * OPS_BUF;
        if (role == 0) {
            if (PASSB) { float E = 1.0f;
#pragma unroll
                for (int s = 0; s < 16; ++s) { const float f = ACT_HG ? 1.0f - bf2f(zr[s]) : lb + (1.0f - lb) * hg_sig(bf2f(zr[s])); E *= fmaxf(f, 1e-30f);
                    const float x = bf2f(qr[s]); const float qv = ACT_HG ? x : x * hg_sig(x);
                    *(LAS unsigned short*)(ob + OPS_Q + s * HG_QP + 2 * ch) = (unsigned short)hg_pk(qv * E, 0.f); } }
        } else { float E = 1.0f; float kin[16];
#pragma unroll
            for (int s = 0; s < 16; ++s) { const float kz = ACT_HG ? bf2f(zr[s]) : 1.0f - (lb + (1.0f - lb) * hg_sig(bf2f(zr[s]))); E *= fmaxf(1.0f - kz, 1e-30f);
                kin[s] = kz * __builtin_amdgcn_rcpf(fmaxf(E, 1e-37f));
                if (PASSB) *(LAS unsigned short*)(ob + OPS_K + s * HG_QP + 2 * ch) = (unsigned short)hg_pk(kin[s], 0.f); }
            v4u w0, w1;
            w0.x = hg_pk(kin[0] * E, kin[1] * E); w0.y = hg_pk(kin[2] * E, kin[3] * E); w0.z = hg_pk(kin[4] * E, kin[5] * E); w0.w = hg_pk(kin[6] * E, kin[7] * E);
            w1.x = hg_pk(kin[8] * E, kin[9] * E); w1.y = hg_pk(kin[10] * E, kin[11] * E); w1.z = hg_pk(kin[12] * E, kin[13] * E); w1.w = hg_pk(kin[14] * E, kin[15] * E);
            *(LAS v4u*)(ob + OPS_KT + ch * 32) = w0; *(LAS v4u*)(ob + OPS_KT + ch * 32 + 16) = w1;
            *(LAS float*)(ob + OPS_D + ch * 4) = E; dtot *= E; }
#pragma unroll
        for (int vt = 0; vt < 2; ++vt)
#pragma unroll
            for (int j = 0; j < 4; ++j) vc[vt][j] = vr[vt][j];
        if (i + 1 < nch) { HG_LOAD_PREP(i + 1) HG_LOAD_V(i + 1) }
        asm volatile("s_waitcnt lgkmcnt(0)" ::: "memory"); __builtin_amdgcn_s_barrier(); asm volatile("" ::: "memory");
        s16x4 vf[2];
#pragma unroll
        for (int vt = 0; vt < 2; ++vt) { v2u t; t.x = (unsigned)vc[vt][0] | ((unsigned)vc[vt][1] << 16); t.y = (unsigned)vc[vt][2] | ((unsigned)vc[vt][3] << 16); vf[vt] = __builtin_bit_cast(s16x4, t); }
        if (PASSB) {
            v4u qp[4], kp[4];
#pragma unroll
            for (int ks = 0; ks < 4; ++ks) {
                const v2u qa = *(const LAS v2u*)(ob + OPS_Q + sl * HG_QP + (32 * ks + 4 * g) * 2), qb = *(const LAS v2u*)(ob + OPS_Q + sl * HG_QP + (32 * ks + 16 + 4 * g) * 2);
                const v2u ka = *(const LAS v2u*)(ob + OPS_K + sl * HG_QP + (32 * ks + 4 * g) * 2), kb = *(const LAS v2u*)(ob + OPS_K + sl * HG_QP + (32 * ks + 16 + 4 * g) * 2);
                qp[ks] = (v4u){qa.x, qa.y, qb.x, qb.y}; kp[ks] = (v4u){ka.x, ka.y, kb.x, kb.y}; }
            f32x4 at = (f32x4){0.f, 0.f, 0.f, 0.f};
#pragma unroll
            for (int ks = 0; ks < 4; ++ks) at = __builtin_amdgcn_mfma_f32_16x16x32_bf16(__builtin_bit_cast(s16x8, kp[ks]), __builtin_bit_cast(s16x8, qp[ks]), at, 0, 0, 0);
            v2u atp; atp.x = hg_pk((4 * g + 0 <= sl) ? at[0] : 0.f, (4 * g + 1 <= sl) ? at[1] : 0.f); atp.y = hg_pk((4 * g + 2 <= sl) ? at[2] : 0.f, (4 * g + 3 <= sl) ? at[3] : 0.f);
            const s16x4 atf = __builtin_bit_cast(s16x4, atp);
            f32x4 o[2];
#pragma unroll
            for (int vt = 0; vt < 2; ++vt) { o[vt] = (f32x4){0.f, 0.f, 0.f, 0.f};
#pragma unroll
                for (int ks = 0; ks < 4; ++ks) { const f32x4 a0 = S[2 * ks][vt], a1 = S[2 * ks + 1][vt];
                    const v4u sa = (v4u){hg_pk(a0[0], a0[1]), hg_pk(a0[2], a0[3]), hg_pk(a1[0], a1[1]), hg_pk(a1[2], a1[3])};
                    o[vt] = __builtin_amdgcn_mfma_f32_16x16x32_bf16(__builtin_bit_cast(s16x8, sa), __builtin_bit_cast(s16x8, qp[ks]), o[vt], 0, 0, 0); }
                o[vt] = __builtin_amdgcn_mfma_f32_16x16x16bf16_1k(vf[vt], atf, o[vt], 0, 0, 0); }
            bf16* orow = (dir ? OBp_ : OFp_) + (size_t)HG_TOK(i, sl) * HGD + h * 128 + wd * 32 + 4 * g;
            *(GAS v2u*)orow = (v2u){hg_pk(o[0][0], o[0][1]), hg_pk(o[0][2], o[0][3])}; *(GAS v2u*)(orow + 16) = (v2u){hg_pk(o[1][0], o[1][1]), hg_pk(o[1][2], o[1][3])};
        }
#pragma unroll
        for (int ct = 0; ct < 8; ++ct) {
            const f32x4 d4 = *(const LAS f32x4*)(ob + OPS_D + (16 * ct + 4 * g) * 4);
            const s16x4 kt = __builtin_bit_cast(s16x4, *(const LAS v2u*)(ob + OPS_KT + (16 * ct + sl) * 32 + 8 * g));
#pragma unroll
            for (int vt = 0; vt < 2; ++vt) S[ct][vt] = __builtin_amdgcn_mfma_f32_16x16x16bf16_1k(kt, vf[vt], S[ct][vt] * d4, 0, 0, 0);
        }
    }
    if (!PASSB) {
        f32x4* sp = (f32x4*)SLOC + ubase * HG_FRAG + (size_t)wd * 1024 + lane;
#pragma unroll
        for (int ct = 0; ct < 8; ++ct)
#pragma unroll
            for (int vt = 0; vt < 2; ++vt) sp[(ct * 2 + vt) * 64] = S[ct][vt];
        if (role == 1) DTOT[ubase * 128 + ch] = dtot;
    }
    asm volatile("s_waitcnt vmcnt(0) lgkmcnt(0)" ::: "memory"); __builtin_amdgcn_s_barrier(); asm volatile("" ::: "memory");
    if (PASSB) {
        const int ntok = (c1 - c0) * 16, sub = lane >> 5, i4 = (lane & 31) * 4;
        const f32x4 gg = *(const GAS f32x4*)(ng + h * 128 + i4);
        for (int tt0 = wave * 2 + sub; tt0 < ntok; tt0 += 16 * HG_FB) {
            v2u aw[HG_FB], bw[HG_FB], cgw[HG_FB];
#pragma unroll
            for (int u = 0; u < HG_FB; ++u) { const int t = tok0 + c0 * 16 + min(tt0 + 16 * u, ntok - 1); const size_t off = (size_t)t * HGD + h * 128 + i4;
                aw[u] = *(const GAS v2u*)(OFp_ + off); bw[u] = *(const GAS v2u*)(OBp_ + off); cgw[u] = *(const GAS v2u*)(P + (size_t)t * DINP + C_CG + h * 128 + i4); }
#pragma unroll
            for (int u = 0; u < HG_FB; ++u) { const int tt = tt0 + 16 * u, t = tok0 + c0 * 16 + tt;
                const f32x4 o = (f32x4){bflo(aw[u].x) + bflo(bw[u].x), bfhi(aw[u].x) + bfhi(bw[u].x), bflo(aw[u].y) + bflo(bw[u].y), bfhi(aw[u].y) + bfhi(bw[u].y)};
                float s = (o.x * o.x + o.y * o.y) + (o.z * o.z + o.w * o.w);
                s += __shfl_xor(s, 1); s += __shfl_xor(s, 2); s += __shfl_xor(s, 4); s += __shfl_xor(s, 8); s += __shfl_xor(s, 16);
                const float rs = 1.0f / sqrtf(s * (1.f / 128.f) + EPS);
                v2u w; w.x = pk2(o.x * rs * gg.x * CGS(bflo(cgw[u].x)), o.y * rs * gg.y * CGS(bfhi(cgw[u].x))); w.y = pk2(o.z * rs * gg.z * CGS(bflo(cgw[u].y)), o.w * rs * gg.w * CGS(bfhi(cgw[u].y)));
                if (tt < ntok) *(GAS v2u*)(Yo + (size_t)t * D + CONVD + NAD + h * 128 + i4) = w; }
        }
    }
#undef HG_TOK
#undef HG_LOAD_PREP
#undef HG_CB
#undef HG_LOAD_V
}
constexpr int SA_KT = 0, SA_D = 128 * 64, SA_BUF = SA_D + 512, SA_DIR = 2 * SA_BUF;
template <int ROLE>
__device__ __forceinline__ void hgrn_state_unit(LAS unsigned char* lds, const bf16* P, float* SLOC, float* DTOT, int tok0, int c0, int c1, int sg, int h) {
    const int tid = opaque_tid(), lane = tid & 63, wave = __builtin_amdgcn_readfirstlane(tid >> 6);
    const int dir = wave >> 2, wd = wave & 3, sl = lane & 15, g = lane >> 4; constexpr int role = ROLE;
    const int ch = (wd & 1) * 64 + lane;
    const int zoff = (dir ? C_CFB : C_CFF) + h * 128, v0 = C_CI + h * 128 + wd * 32;
    LAS unsigned char* const od = lds + dir * SA_DIR;
    const int ntok = (c1 - c0) * 16, nC = (ntok + 31) >> 5, tokS = tok0 + c0 * 16, tokE = tok0 + c1 * 16;
    const size_t ubase = (size_t)((sg * HGH + h) * 2 + dir);
    f32x4 S[8][2];
#pragma unroll
    for (int ct = 0; ct < 8; ++ct)
#pragma unroll
        for (int vt = 0; vt < 2; ++vt) S[ct][vt] = (f32x4){0.f, 0.f, 0.f, 0.f};
    float dtot = 1.0f;
    unsigned short zr[32]; unsigned vr[2][8], vc[2][8];
#define SA_TOK(p) (dir ? (tokE - 1 - (p)) : (tokS + (p)))
    constexpr size_t ROWB = (size_t)DINP * 2;
    const unsigned vo_z = (unsigned)(zoff + ch) * 2u, vo_vf = (unsigned)((dir ? 24 - 8 * g : 8 * g) * (DINP * 2) + (v0 + sl) * 2), vo_vh = (unsigned)((dir ? 8 - 8 * (g & 1) : 8 * (g & 1)) * (DINP * 2) + (v0 + sl) * 2);
    const __amdgpu_buffer_rsrc_t srd = p_rsrc(P);
#define SA_LOAD(j) { const bool hl_ = 32 * (j) + 32 > ntok; \
        if (role == 1) { const unsigned az_ = (unsigned)(dir ? tokE - 1 - 32 * (j) : tokS + 32 * (j)) * (unsigned)ROWB; \
            _Pragma("unroll") for (int s = 0; s < 32; ++s) { const unsigned d_ = (unsigned)((s > 15 && hl_) ? 15 : s) * (unsigned)ROWB; zr[s] = PB16(srd, vo_z, dir ? az_ - d_ : az_ + d_); } } \
        const unsigned vo_v_ = hl_ ? vo_vh : vo_vf, av_ = (unsigned)(dir ? tokE - (hl_ ? 16 : 32) - 32 * (j) : tokS + 32 * (j)) * (unsigned)ROWB;     \
        _Pragma("unroll") for (int e = 0; e < 8; ++e) { const unsigned so_ = av_ + (unsigned)(dir ? 7 - e : e) * (unsigned)ROWB; vr[0][e] = (unsigned)PB16(srd, vo_v_, so_); vr[1][e] = (unsigned)PB16(srd, vo_v_ + 32u, so_); } }
    SA_LOAD(0)
    for (int j = 0; j < nC; ++j) {
        LAS unsigned char* const ob = od + (j & 1) * SA_BUF;
        if (role == 1) { float R = 1.0f; float kpp[32];
            const bool hl_ = 32 * j + 32 > ntok;
#pragma unroll
            for (int s = 31; s >= 0; --s) { const float kz = (s >= 16 && hl_) ? 0.f : bf2f(zr[s]); kpp[s] = kz * R; R *= fmaxf(1.0f - kz, 1e-30f); }
#pragma unroll
            for (int q4 = 0; q4 < 4; ++q4) { v4u w; w.x = hg_pk(kpp[8 * q4 + 0], kpp[8 * q4 + 1]); w.y = hg_pk(kpp[8 * q4 + 2], kpp[8 * q4 + 3]); w.z = hg_pk(kpp[8 * q4 + 4], kpp[8 * q4 + 5]); w.w = hg_pk(kpp[8 * q4 + 6], kpp[8 * q4 + 7]);
                *(LAS v4u*)(ob + SA_KT + ch * 64 + q4 * 16) = w; }
            *(LAS float*)(ob + SA_D + ch * 4) = R; dtot *= R; }
#pragma unroll
        for (int vt = 0; vt < 2; ++vt)
#pragma unroll
            for (int e = 0; e < 8; ++e) vc[vt][e] = vr[vt][e];
        if (j + 1 < nC) { SA_LOAD(j + 1) }
        asm volatile("s_waitcnt lgkmcnt(0)" ::: "memory"); __builtin_amdgcn_s_barrier(); asm volatile("" ::: "memory");
        s16x8 vf[2];
#pragma unroll
        for (int vt = 0; vt < 2; ++vt) { v4u t; t.x = vc[vt][0] | (vc[vt][1] << 16); t.y = vc[vt][2] | (vc[vt][3] << 16); t.z = vc[vt][4] | (vc[vt][5] << 16); t.w = vc[vt][6] | (vc[vt][7] << 16);
            vf[vt] = __builtin_bit_cast(s16x8, t); }
#pragma unroll
        for (int ct = 0; ct < 8; ++ct) {
            const f32x4 d4 = *(const LAS f32x4*)(ob + SA_D + (16 * ct + 4 * g) * 4);
            const s16x8 kt = __builtin_bit_cast(s16x8, *(const LAS v4u*)(ob + SA_KT + (16 * ct + sl) * 64 + g * 16));
#pragma unroll
            for (int vt = 0; vt < 2; ++vt) S[ct][vt] = __builtin_amdgcn_mfma_f32_16x16x32_bf16(kt, vf[vt], S[ct][vt] * d4, 0, 0, 0);
        }
    }
    f32x4* sp = (f32x4*)SLOC + ubase * HG_FRAG + (size_t)wd * 1024 + lane;
#pragma unroll
    for (int ct = 0; ct < 8; ++ct)
#pragma unroll
        for (int vt = 0; vt < 2; ++vt) sp[(ct * 2 + vt) * 64] = S[ct][vt];
    if (role == 1) DTOT[ubase * 128 + ch] = dtot;
    asm volatile("s_waitcnt vmcnt(0) lgkmcnt(0)" ::: "memory"); __builtin_amdgcn_s_barrier(); asm volatile("" ::: "memory");
#undef SA_TOK
#undef SA_LOAD
}
__device__ __forceinline__ void hg_seg_range(int sg, int nseq, int L, int& tok0, int& c0, int& c1) {
    const int nss = HG_NSEG / nseq, sq = sg / nss, si = sg - sq * nss, n = L / 16;
    tok0 = sq * L; c0 = (si * n) / nss; c1 = ((si + 1) * n) / nss;
}
__device__ __forceinline__ void hgrn_scan_phase(float* SLOC, const float* DTOT, int nseq) {
    const int tid = opaque_tid(); const int gt = opaque_bid() * (NWAVES * 64) + tid, NT = opaque_G() * NWAVES * 64;
    const int nss = HG_NSEG / nseq;
    for (int e = gt; e < HGH * 2 * (int)HG_FRAG; e += NT) {
        const int hd = e >> 12, f = e & 4095, h = hd >> 1, dir = hd & 1, ct = (f >> 7) & 7, g = (f & 63) >> 4;
        for (int sq = 0; sq < nseq; ++sq) {
            f32x4 S = (f32x4){0.f, 0.f, 0.f, 0.f};
            for (int j0 = 0; j0 < nss; j0 += 21) {
                f32x4 tmp[21], d[21];
#pragma unroll
                for (int k = 0; k < 21; ++k) if (j0 + k < nss) { const int j = dir ? (nss - 1 - (j0 + k)) : (j0 + k); const size_t ub = (size_t)(((sq * nss + j) * HGH + h) * 2 + dir);
                    tmp[k] = *((const GAS f32x4*)SLOC + ub * HG_FRAG + f); d[k] = *(const GAS f32x4*)(DTOT + ub * 128 + 16 * ct + 4 * g); }
#pragma unroll
                for (int k = 0; k < 21; ++k) if (j0 + k < nss) { const int j = dir ? (nss - 1 - (j0 + k)) : (j0 + k); const size_t ub = (size_t)(((sq * nss + j) * HGH + h) * 2 + dir);
                    *((GAS f32x4*)SLOC + ub * HG_FRAG + f) = S; S = d[k] * S + tmp[k]; }
            }
        }
    }
}

constexpr int RPB_LDS_OFF = 65536;
__device__ __forceinline__ void attn_unit(const LAS float* rpbL, const bf16* P, const bf16* VT, const float* RSg, bf16* Y, int tok0, int rows, int r, int jb, int h, int lane) {
    const int sl = lane & 15, g = lane >> 4;
    const int rs = min(max(r - 4, 0), rows - 8), ks0 = min(max(16 * jb - 8, 0), 32);
    const size_t qtok = (size_t)(tok0 + r * 64 + 16 * jb + sl);
    const s16x8 qf0 = __builtin_bit_cast(s16x8, *(const GAS v4u*)(P + qtok * DINP + C_NQ + h * 64 + 8 * g)), qf1 = __builtin_bit_cast(s16x8, *(const GAS v4u*)(P + qtok * DINP + C_NQ + h * 64 + 32 + 8 * g));
    float sc[8][8];
    const bf16* kbase = P + (size_t)(tok0 + rs * 64 + ks0 + 8 * (sl >> 2) + (sl & 3)) * DINP + C_NK + h * 64 + 8 * g;
    v4u kr[8][2][2];
#pragma unroll
    for (int i = 0; i < 8; ++i)
#pragma unroll
        for (int hf = 0; hf < 2; ++hf) { const bf16* kp = kbase + (size_t)(i * 64 + 4 * hf) * DINP; kr[i][hf][0] = *(const GAS v4u*)kp; kr[i][hf][1] = *(const GAS v4u*)(kp + 32); }
    __builtin_amdgcn_sched_barrier(0);
#pragma unroll
    for (int i = 0; i < 8; ++i)
#pragma unroll
        for (int hf = 0; hf < 2; ++hf) {
            f32x4 a = (f32x4){0.f, 0.f, 0.f, 0.f};
            a = __builtin_amdgcn_mfma_f32_16x16x32_bf16(__builtin_bit_cast(s16x8, kr[i][hf][0]), qf0, a, 0, 0, 0); a = __builtin_amdgcn_mfma_f32_16x16x32_bf16(__builtin_bit_cast(s16x8, kr[i][hf][1]), qf1, a, 0, 0, 0);
            sc[i][4 * hf + 0] = a[0]; sc[i][4 * hf + 1] = a[1]; sc[i][4 * hf + 2] = a[2]; sc[i][4 * hf + 3] = a[3]; }
    __builtin_amdgcn_sched_barrier(0);
    const int c = 16 * jb + sl, cs = min(max(c - 8, 0), 48);
    const LAS float* bb = rpbL + h * (15 * 31) + (rs - r + 7) * 31;
    int dco[8]; bool okv[8];
#pragma unroll
    for (int e = 0; e < 8; ++e) { const int kc = ks0 + 8 * g + e; okv[e] = (kc >= cs) && (kc < cs + 16); dco[e] = min(max(kc - c + 15, 0), 30); }
    float mx = -1e30f;
#pragma unroll
    for (int i = 0; i < 8; ++i)
#pragma unroll
        for (int e = 0; e < 8; ++e) { const float bv = bb[i * 31 + dco[e]];
            const float s = okv[e] ? sc[i][e] * (ACT_Q8 ? 1.0f : 0.125f) + bv : -1e30f;
            sc[i][e] = s; mx = fmaxf(mx, s); }
    mx = fmaxf(mx, __shfl_xor(mx, 16)); mx = fmaxf(mx, __shfl_xor(mx, 32));
    float sum = 0.f;
#pragma unroll
    for (int i = 0; i < 8; ++i)
#pragma unroll
        for (int e = 0; e < 8; ++e) { const float pv = __expf(sc[i][e] - mx); sc[i][e] = pv; sum += pv; }
    sum += __shfl_xor(sum, 16); sum += __shfl_xor(sum, 32);
    f32x4 o[4];
#pragma unroll
    for (int dt = 0; dt < 4; ++dt) o[dt] = (f32x4){0.f, 0.f, 0.f, 0.f};
    const bf16* vbase = VT + (size_t)(h * 64 + sl) * GT + tok0 + rs * 64 + ks0 + 8 * g;
#pragma unroll
    for (int i = 0; i < 8; ++i) {
        const v4u pw = (v4u){hg_pk(sc[i][0], sc[i][1]), hg_pk(sc[i][2], sc[i][3]), hg_pk(sc[i][4], sc[i][5]), hg_pk(sc[i][6], sc[i][7])};
#pragma unroll
        for (int dt = 0; dt < 4; ++dt) { const s16x8 vf = __builtin_bit_cast(s16x8, *(const GAS v4u*)(vbase + (size_t)(16 * dt) * GT + i * 64));
            o[dt] = __builtin_amdgcn_mfma_f32_16x16x32_bf16(vf, __builtin_bit_cast(s16x8, pw), o[dt], 0, 0, 0); } }
    const float inv = 1.0f / sum;
    bf16* yp = Y + qtok * D + CONVD + h * 64 + 4 * g;
#pragma unroll
    for (int dt = 0; dt < 4; ++dt) { v2u w; w.x = hg_pk(o[dt][0] * inv, o[dt][1] * inv); w.y = hg_pk(o[dt][2] * inv, o[dt][3] * inv); *(GAS v2u*)(yp + 16 * dt) = w; }
}

__device__ __forceinline__ void panel_rs_table(LAS float* rsl, const float* part, float* rsg, int pm) {
    const int tid = opaque_tid(), row = tid >> 1, half = tid & 1;
    const GAS float* p1 = (const GAS float*)part + (size_t)(half * 16) * GT + pm * 256 + row;
    float v[16];
#pragma unroll
    for (int k = 0; k < 16; ++k) v[k] = p1[(size_t)k * GT];
    float s = (((v[0] + v[1]) + (v[2] + v[3])) + ((v[4] + v[5]) + (v[6] + v[7]))) + (((v[8] + v[9]) + (v[10] + v[11])) + ((v[12] + v[13]) + (v[14] + v[15])));
    s += __shfl_xor(s, 1);
    const float rs = 1.0f / sqrtf(s * (1.0f / D) + EPS);
    if (half == 0) { rsl[row] = rs; if (rsg) rsg[pm * 256 + row] = rs; }
    __syncthreads();
}
constexpr int AT_KOFF = 0, AT_VOFF = 65536, AT_BIAS = 133120, AT_MRG = AT_BIAS + 2048, AT_MRG_JB = 2560;
static_assert(AT_MRG + 4 * AT_MRG_JB <= LDS_BYTES, "attention scratch fits above the ring");
constexpr int AT_BAND = 16;
__device__ __forceinline__ void attn_band(LAS unsigned char* lds, const bf16* P, const bf16* VT, const float* rpb_h, bf16* Y, int tok0, int rows, int r0, int h) {
    const int tid = opaque_tid(), lane = tid & 63, wave = __builtin_amdgcn_readfirstlane(tid >> 6), sl = lane & 15, g = lane >> 4, jb = wave & 3, half = wave >> 2;
    for (int i = tid; i < 15 * 31; i += NWAVES * 64) ((LAS float*)(lds + AT_BIAS))[i] = rpb_h[i] * 1.4426950408889634f;
    const int lk = tid >> 3, lc = tid & 7, lswk = lk * 128 + ((lc ^ (((lk >> 3) & 3) | ((lk & 2) << 1))) * 16), lswv = lk * 128 + ((lc ^ ((lk >> 1) & 7)) * 16);
    const bf16* const kcol = P + (size_t)(tok0 + lk) * DINP + C_NK + h * 64 + lc * 8;
    const bf16* const vrow = VT + (size_t)(h * 64 + lk) * GT + tok0 + lc * 8;
    {
        const int rs0 = min(max(r0 - 4, 0), rows - 8);
        v4u kq[8], vq[8];
#pragma unroll
        for (int i = 0; i < 8; ++i) { kq[i] = *(const GAS v4u*)(kcol + (size_t)((rs0 + i) * 64) * DINP); vq[i] = *(const GAS v4u*)(vrow + (rs0 + i) * 64); }
#pragma unroll
        for (int i = 0; i < 8; ++i) { const int slot = (rs0 + i) & 7; *(LAS v4u*)(lds + AT_KOFF + slot * 8192 + lswk) = kq[i]; *(LAS v4u*)(lds + AT_VOFF + slot * 8192 + lswv) = vq[i]; }
    }
    asm volatile("s_waitcnt lgkmcnt(0)" ::: "memory"); __builtin_amdgcn_s_barrier(); asm volatile("" ::: "memory");
    const int ks0 = min(max(16 * jb - 8, 0), 32), c = 16 * jb + sl, cs = min(max(c - 8, 0), 48);
    int dco[8]; bool okv[8];
#pragma unroll
    for (int e = 0; e < 8; ++e) { const int kc = ks0 + 8 * g + e; okv[e] = (kc >= cs) && (kc < cs + 16); dco[e] = min(max(kc - c + 15, 0), 30); }
    v4u qn0, qn1;
    { const bf16* qp = P + (size_t)(tok0 + r0 * 64 + c) * DINP + C_NQ + h * 64 + 8 * g; qn0 = *(const GAS v4u*)qp; qn1 = *(const GAS v4u*)(qp + 32); }
    int bcur = 1 << 20; float bvc[4][8];
    for (int rq = r0; rq < r0 + AT_BAND; ++rq) {
        const int rs = min(max(rq - 4, 0), rows - 8), rsn = min(max(rq - 3, 0), rows - 8);
        const bool adv = (rq + 1 < r0 + AT_BAND) && (rsn != rs);
        v4u kn, vn;
        if (adv) { kn = *(const GAS v4u*)(kcol + (size_t)((rs + 8) * 64) * DINP); vn = *(const GAS v4u*)(vrow + (rs + 8) * 64); }
        const size_t qtok = (size_t)(tok0 + rq * 64 + c);
        const s16x8 qf0 = __builtin_bit_cast(s16x8, qn0), qf1 = __builtin_bit_cast(s16x8, qn1);
        if (rq + 1 < r0 + AT_BAND) { const bf16* qp = P + (qtok + 64) * DINP + C_NQ + h * 64 + 8 * g; qn0 = *(const GAS v4u*)qp; qn1 = *(const GAS v4u*)(qp + 32); }
        float sc[4][8];
#pragma unroll
        for (int ii = 0; ii < 4; ++ii) { const int slot = (rs + 4 * half + ii) & 7;
#pragma unroll
            for (int hf = 0; hf < 2; ++hf) { const int key = ks0 + 8 * (sl >> 2) + 4 * hf + (sl & 3); const LAS unsigned char* kp = lds + AT_KOFF + slot * 8192 + key * 128;
                const int fk = ((key >> 3) & 3) | ((key & 2) << 1);
                const s16x8 k0 = __builtin_bit_cast(s16x8, *(const LAS v4u*)(kp + ((g ^ fk) * 16))), k1 = __builtin_bit_cast(s16x8, *(const LAS v4u*)(kp + (((4 + g) ^ fk) * 16)));
                f32x4 a = (f32x4){0.f, 0.f, 0.f, 0.f};
                a = __builtin_amdgcn_mfma_f32_16x16x32_bf16(k0, qf0, a, 0, 0, 0); a = __builtin_amdgcn_mfma_f32_16x16x32_bf16(k1, qf1, a, 0, 0, 0);
                sc[ii][4 * hf + 0] = a[0]; sc[ii][4 * hf + 1] = a[1]; sc[ii][4 * hf + 2] = a[2]; sc[ii][4 * hf + 3] = a[3]; } }
        if (rs - rq != bcur) { bcur = rs - rq;
            const LAS float* bb = (const LAS float*)(lds + AT_BIAS) + (bcur + 4 * half + 7) * 31;
#pragma unroll
            for (int ii = 0; ii < 4; ++ii)
#pragma unroll
                for (int e = 0; e < 8; ++e) bvc[ii][e] = okv[e] ? bb[ii * 31 + dco[e]] : -1e30f; }
        float mx = -1e30f;
#pragma unroll
        for (int ii = 0; ii < 4; ++ii)
#pragma unroll
            for (int e = 0; e < 8; ++e) { const float s = sc[ii][e] + bvc[ii][e]; sc[ii][e] = s; mx = fmaxf(mx, s); }
        mx = fmaxf(mx, __shfl_xor(mx, 16)); mx = fmaxf(mx, __shfl_xor(mx, 32));
        float sum = 0.f;
#pragma unroll
        for (int ii = 0; ii < 4; ++ii)
#pragma unroll
            for (int e = 0; e < 8; ++e) { const float pv = __builtin_amdgcn_exp2f(sc[ii][e] - mx); sc[ii][e] = pv; sum += pv; }
        sum += __shfl_xor(sum, 16); sum += __shfl_xor(sum, 32);
        f32x4 o[4];
#pragma unroll
        for (int dt = 0; dt < 4; ++dt) o[dt] = (f32x4){0.f, 0.f, 0.f, 0.f};
#pragma unroll
        for (int ii = 0; ii < 4; ++ii) { const int slot = (rs + 4 * half + ii) & 7;
            const v4u pw = (v4u){hg_pk(sc[ii][0], sc[ii][1]), hg_pk(sc[ii][2], sc[ii][3]), hg_pk(sc[ii][4], sc[ii][5]), hg_pk(sc[ii][6], sc[ii][7])};
#pragma unroll
            for (int dt = 0; dt < 4; ++dt) { const int d = 16 * dt + sl;
                const s16x8 vf = __builtin_bit_cast(s16x8, *(const LAS v4u*)(lds + AT_VOFF + slot * 8192 + d * 128 + ((((ks0 >> 3) + g) ^ ((d >> 1) & 7)) * 16)));
                o[dt] = __builtin_amdgcn_mfma_f32_16x16x32_bf16(vf, __builtin_bit_cast(s16x8, pw), o[dt], 0, 0, 0); } }
        LAS unsigned char* mg = lds + AT_MRG + jb * AT_MRG_JB;
        if (half == 1) {
            *(LAS v4u*)(mg + lane * 32) = (v4u){hg_pk(o[0][0], o[0][1]), hg_pk(o[0][2], o[0][3]), hg_pk(o[1][0], o[1][1]), hg_pk(o[1][2], o[1][3])};
            *(LAS v4u*)(mg + lane * 32 + 16) = (v4u){hg_pk(o[2][0], o[2][1]), hg_pk(o[2][2], o[2][3]), hg_pk(o[3][0], o[3][1]), hg_pk(o[3][2], o[3][3])};
            *(LAS v2u*)(mg + 2048 + lane * 8) = (v2u){__float_as_uint(mx), __float_as_uint(sum)};
        }
        asm volatile("s_waitcnt lgkmcnt(0)" ::: "memory"); __builtin_amdgcn_s_barrier(); asm volatile("" ::: "memory");
        if (half == 0) {
            const v4u p0 = *(const LAS v4u*)(mg + lane * 32), p1 = *(const LAS v4u*)(mg + lane * 32 + 16); const v2u ml = *(const LAS v2u*)(mg + 2048 + lane * 8);
            const float mx2 = __uint_as_float(ml.x), m = fmaxf(mx, mx2), a = __builtin_amdgcn_exp2f(mx - m), b = __builtin_amdgcn_exp2f(mx2 - m), inv = 1.0f / (a * sum + b * __uint_as_float(ml.y));
            const float ai = a * inv, bi = b * inv;
            bf16* yp = Y + qtok * D + CONVD + h * 64 + 4 * g;
            v2u w;
            w.x = hg_pk(o[0][0] * ai + bflo(p0.x) * bi, o[0][1] * ai + bfhi(p0.x) * bi); w.y = hg_pk(o[0][2] * ai + bflo(p0.y) * bi, o[0][3] * ai + bfhi(p0.y) * bi); *(GAS v2u*)(yp) = w;
            w.x = hg_pk(o[1][0] * ai + bflo(p0.z) * bi, o[1][1] * ai + bfhi(p0.z) * bi); w.y = hg_pk(o[1][2] * ai + bflo(p0.w) * bi, o[1][3] * ai + bfhi(p0.w) * bi); *(GAS v2u*)(yp + 16) = w;
            w.x = hg_pk(o[2][0] * ai + bflo(p1.x) * bi, o[2][1] * ai + bfhi(p1.x) * bi); w.y = hg_pk(o[2][2] * ai + bflo(p1.y) * bi, o[2][3] * ai + bfhi(p1.y) * bi); *(GAS v2u*)(yp + 32) = w;
            w.x = hg_pk(o[3][0] * ai + bflo(p1.z) * bi, o[3][1] * ai + bfhi(p1.z) * bi); w.y = hg_pk(o[3][2] * ai + bflo(p1.w) * bi, o[3][3] * ai + bfhi(p1.w) * bi); *(GAS v2u*)(yp + 48) = w;
        }
        if (adv) { const int slot = rs & 7; *(LAS v4u*)(lds + AT_KOFF + slot * 8192 + lswk) = kn; *(LAS v4u*)(lds + AT_VOFF + slot * 8192 + lswv) = vn; }
        asm volatile("s_waitcnt lgkmcnt(0)" ::: "memory"); __builtin_amdgcn_s_barrier(); asm volatile("" ::: "memory");
    }
}

#ifndef REP_NORM
#define REP_NORM 1
#endif
#ifndef REP_WIN
#define REP_WIN 1
#endif
#ifndef REP_MIX
#define REP_MIX 1
#endif
#ifndef REP_HG
#define REP_HG 1
#endif
#ifndef REP_FIN
#define REP_FIN 1
#endif
#ifndef REP_HGA
#define REP_HGA 1
#endif
#ifndef REP_CONV
#define REP_CONV 1
#endif
#ifndef REP_ATT
#define REP_ATT 1
#endif
#ifndef REP_HGB
#define REP_HGB 1
#endif
#ifndef REP_BR
#define REP_BR 1
#endif
#ifndef REP_FFN1
#define REP_FFN1 1
#endif
struct Args { const float* in[17]; float* out; unsigned char* ws; };
__global__ void __launch_bounds__(NWAVES * 64, 2) fwd_kernel(Args args) {
    extern __shared__ __attribute__((aligned(16))) unsigned char lds[];
    Frame F;
    F.lds = (LAS unsigned char*)lds;
    F.MISC = (volatile LAS unsigned*)(F.lds + MISC_OFF);
    (void)args;
    for (int u = threadIdx.x; u < (LDS_BYTES - LDSCTL_OFF) / 4; u += NWAVES * 64) ((LAS unsigned*)(F.lds + LDSCTL_OFF))[u] = 0u;
    __syncthreads();
    (void)xcd_barrier_post((unsigned*)(arg_ws() + WS_CTL) + CW_BAR, F.MISC + 8);
    { unsigned* xw_ = (unsigned*)(arg_ws() + WS_CTL) + CW_XCC + opaque_bid(); const unsigned xv_ = xb_xcc_id() + 1u; if (opaque_tid() == 0) (void)xb_add(xw_, xv_); }
#define GRID_BAR() do { XcdBarrier bar_; bar_.bar = (unsigned*)(arg_ws() + WS_CTL) + CW_BAR; bar_.x = xb_xcc_id(); bar_.st = F.MISC + 8; xcd_barrier(bar_); } while (0)

    p0_prologue(F);
    x_rows_prepare(F, arg_in(0), (bf16*)(arg_ws() + WS_XB), (float*)(arg_ws() + WS_PART), GT, -1);
    GRID_BAR();
    int pm_own;
    { pg8::StaticOrder S; S.init(GT, D, opaque_G(), opaque_bid()); pg8::Unit u0; S.next(0, u0); pm_own = u0.pm; asm volatile("" : "+s"(pm_own)); }
    {
        const int bid_ = opaque_bid(), G_ = opaque_G(); unsigned* w = (unsigned*)(arg_ws() + WS_CTL); const unsigned mine = xb_xcc_id() + 1u;
        int same = (G_ == 256) ? 1 : 0;
#pragma unroll
        for (int r = 0; r < 4; ++r) { const int cc = (bid_ & 63) + 64 * r; pg8::StaticOrder S; S.init(GT, D, G_, cc); pg8::Unit u0; S.next(0, u0); same &= (u0.pm == pm_own) ? 1 : 0; }
        if (opaque_tid() == 0) {
            unsigned ok = 1u;
#pragma unroll
            for (int r = 0; r < 4; ++r) ok &= (xb_ld(w + CW_XCC + (bid_ & 63) + 64 * r) == mine) ? 1u : 0u;
            if (!same || !ok) (void)xb_add(w + CW_MISM, 1u);
        }
    }

#define MIX ((bf16*)(arg_ws() + WS_H))
#define XB ((bf16*)(arg_ws() + WS_XB))
#define PART(k) ((float*)(arg_ws() + WS_PART) + (size_t)(k) * GT * 32)
#define RSL ((LAS float*)(F.lds + RSL_OFF))
#define PANEL_BAR() do { if (__builtin_amdgcn_readfirstlane((int)F.MISC[104])) panel_barrier(F, pm_own); else GRID_BAR(); } while (0)
#define Y ((bf16*)(arg_ws() + WS_Y))
#define P ((bf16*)(arg_ws() + WS_P))
#define OFp ((bf16*)(arg_ws() + WS_OF))
#define OBp ((bf16*)(arg_ws() + WS_OB))
#define xin ((g < 2) ? arg_in(0) + (size_t)g * GT * D : arg_in(1))
#define X (arg_out() + (size_t)g * GT * D)
#define wl ((const bf16*)(arg_ws() + WS_W + (size_t)l * LW))
    for (int g = 0; g < NG; ++g) {
        const int L = (g < 2) ? 8192 : 16384, nseq = GT / L, rows = L / 64;
        if (g > 0) { const int own_ = __builtin_amdgcn_readfirstlane((int)F.MISC[104]) ? pm_own * 256 + (opaque_bid() >> 6) * 64 : -1;
            x_rows_prepare(F, xin, XB, PART(0), GT, own_); PANEL_BAR(); }
        for (int l = 0; l < DEPTH; ++l) {
            for (int rep_ = 0; rep_ < REP_WIN; ++rep_) {
            { pg8::Gemm gm{XB, wl + LW_IN / 2, GT, DINP, D, D, D}; pg8::StaticOrder S; S.init(GT, DINP, opaque_G(), opaque_bid());
              { pg8::Unit u0; S.next(0, u0); panel_rs_table(RSL, PART(0), nullptr, u0.pm); }
              pg8::EpiP16 E{P, DINP, RSL, (const float*)(arg_ws() + WS_LB) + l * 2 * HGD - C_CFF, (unsigned char*)(arg_ws() + WS_G8), 6144};
              pg8::gemm_phase<pg8::EpiP16, pg8::StaticOrder, true, true>(F.lds + RING_OFF, gm, S, E); }
            { pg8::Gemm gm{wl + LW_IN / 2 + (size_t)DINP * D, XB, NAD, GT, D, D, D}; const int c_ = opaque_bid(); pg8::OneUnit S{c_ >> 6, 8 * (c_ & 7) + ((c_ >> 3) & 7), (c_ >> 6) < 3 ? 1 : 0};
              pg8::EpiVT E{(bf16*)(arg_ws() + WS_VT), GT, RSL};
              pg8::gemm_phase<pg8::EpiVT, pg8::OneUnit, true, true>(F.lds + RING_OFF, gm, S, E); }
            }
            GRID_BAR();
            if (g == 0 && l == 0) { if (opaque_tid() == 0) F.MISC[104] = (xb_ld((unsigned*)(arg_ws() + WS_CTL) + CW_MISM) == 0u) ? 1u : 0u; __syncthreads(); }
            for (int rep_ = 0; rep_ < REP_MIX; ++rep_) {
            for (int ra2_ = 0; ra2_ < REP_ATT; ++ra2_)
            { const int u = opaque_bid(), nb = rows / AT_BAND; if (u < nseq * NAH * nb) { const int bnd = u % nb, hh = (u / nb) % NAH, sq = u / (nb * NAH);
                attn_band(F.lds, P, (const bf16*)(arg_ws() + WS_VT), arg_in(5) + (size_t)(l * NAH + hh) * 15 * 31, Y, sq * L, rows, bnd * AT_BAND, hh); } }
            __syncthreads();
            }
            for (int rep_ = 0; rep_ < REP_HG; ++rep_) {
            for (int ra_ = 0; ra_ < REP_HGA; ++ra_)
            { const int u = opaque_bid(); if (u < HG_NSEG * HGH) { const int sg = u / HGH, hh = u - sg * HGH; int tk0, c0, c1; hg_seg_range(sg, nseq, L, tk0, c0, c1);
                { const int wv_ = __builtin_amdgcn_readfirstlane(opaque_tid() >> 6);
                  if ((((wv_ & 3) >> 1) ^ (wv_ >> 2)) == 0) hgrn_state_unit<0>(F.lds + RING_OFF, P, (float*)(arg_ws() + WS_SLOC), (float*)(arg_ws() + WS_DTOT), tk0, c0, c1, sg, hh);
                  else hgrn_state_unit<1>(F.lds + RING_OFF, P, (float*)(arg_ws() + WS_SLOC), (float*)(arg_ws() + WS_DTOT), tk0, c0, c1, sg, hh); } } }
            conv_phase(F, P, Y, arg_in(4) + l * 3 * CONVD, L, (unsigned*)(arg_ws() + WS_CTL) + CW_CONV + (g * DEPTH + l) * 32);
            GRID_BAR();
            hgrn_scan_phase((float*)(arg_ws() + WS_SLOC), (const float*)(arg_ws() + WS_DTOT), nseq);
            GRID_BAR();
            for (int rb_ = 0; rb_ < REP_HGB; ++rb_)
            { const int u = opaque_bid(); if (u < HG_NSEG * HGH) { const int sg = u / HGH, hh = u - sg * HGH; int tk0, c0, c1; hg_seg_range(sg, nseq, L, tk0, c0, c1);
                { const int wv_ = __builtin_amdgcn_readfirstlane(opaque_tid() >> 6);
                  if ((((wv_ & 3) >> 1) ^ (wv_ >> 2)) == 0) hgrn_unit<true, 0>(F.lds + RING_OFF, P, (const float*)(arg_ws() + WS_LB) + l * 2 * HGD, (float*)(arg_ws() + WS_SLOC), (float*)(arg_ws() + WS_DTOT), OFp, OBp, arg_in(7) + l * HGD, Y, tk0, c0, c1, sg, hh);
                  else hgrn_unit<true, 1>(F.lds + RING_OFF, P, (const float*)(arg_ws() + WS_LB) + l * 2 * HGD, (float*)(arg_ws() + WS_SLOC), (float*)(arg_ws() + WS_DTOT), OFp, OBp, arg_in(7) + l * HGD, Y, tk0, c0, c1, sg, hh); } } }
            GRID_BAR();
            }
            for (int rep_ = 0; rep_ < REP_BR; ++rep_)
            { pg8::Gemm gm{Y, wl + LW_BC / 2, GT, D, D, D, D}; pg8::StaticOrder S; S.init(GT, D, opaque_G(), opaque_bid());
              pg8::EpiGate16 E{(const unsigned char*)(arg_ws() + WS_G8), 6144, MIX, D};
              pg8::gemm_phase<pg8::EpiGate16, pg8::StaticOrder, true, true>(F.lds + RING_OFF, gm, S, E); }
            PANEL_BAR();
            { pg8::Gemm gm{MIX, wl + LW_MO / 2, GT, D, D, D, D}; pg8::StaticOrder S; S.init(GT, D, opaque_G(), opaque_bid());
              pg8::EpiResid E{XB, PART(1), D, GT};
              pg8::gemm_phase<pg8::EpiResid, pg8::StaticOrder, true, true>(F.lds + RING_OFF, gm, S, E); }
            PANEL_BAR();
            for (int rep_ = 0; rep_ < REP_FFN1; ++rep_) {
            { pg8::Gemm gm{XB, wl + LW_GU / 2, GT, DGU, D, D, D}; pg8::StaticOrder S; S.init(GT, DGU, opaque_G(), opaque_bid());
              { pg8::Unit u0; S.next(0, u0); panel_rs_table(RSL, PART(1), nullptr, u0.pm); }
              pg8::EpiSwiglu E{P, DINP, RSL};
              pg8::gemm_phase<pg8::EpiSwiglu, pg8::StaticOrder, true, true>(F.lds + RING_OFF, gm, S, E); }
            }
            PANEL_BAR();
            { pg8::Gemm gm{P, wl + LW_D / 2, GT, D, DFF, DINP, DFF}; pg8::StaticOrder S; S.init(GT, D, opaque_G(), opaque_bid());
              pg8::EpiResid E{XB, PART(0), D, GT};
              pg8::gemm_phase<pg8::EpiResid, pg8::StaticOrder, true, true>(F.lds + RING_OFF, gm, S, E); }
            PANEL_BAR();
        }
        if (__builtin_amdgcn_readfirstlane((int)F.MISC[104])) norm_rows_final(F, XB, X, arg_in(16), GT, pm_own * 256 + (opaque_bid() >> 6) * 64);
        else { norm_rows_final(F, XB, X, arg_in(16), GT, -1); GRID_BAR(); }
    }
}

extern "C" void kernel_launch(void* const* d_in, const int* in_sizes, int n_in, void* d_out, int out_size, void* d_ws, size_t ws_size, hipStream_t stream) {
    static int grid = 0;
    if (grid == 0) {
        if (n_in != 17 || out_size != TOK * D || ws_size < WS_END) { fprintf(stderr, "kernel_launch: unexpected shapes (n_in %d, out %d, ws %zu, need %zu); nothing launched\n", n_in, out_size, ws_size, (size_t)WS_END); grid = -1; return; }
        int dev = 0, cus = 0, per_cu = 0;
        if (hipGetDevice(&dev) != hipSuccess || hipDeviceGetAttribute(&cus, hipDeviceAttributeMultiprocessorCount, dev) != hipSuccess) { grid = -1; return; }
        if (hipFuncSetAttribute((const void*)fwd_kernel, hipFuncAttributeMaxDynamicSharedMemorySize, LDS_BYTES) != hipSuccess) { fprintf(stderr, "kernel_launch: hipFuncSetAttribute failed\n"); grid = -1; return; }
        if (hipOccupancyMaxActiveBlocksPerMultiprocessor(&per_cu, (const void*)fwd_kernel, NWAVES * 64, LDS_BYTES) != hipSuccess || per_cu < 1) { fprintf(stderr, "kernel_launch: occupancy query says %d blocks per CU\n", per_cu); per_cu = 1; }
        (void)hipGetLastError();
        grid = cus;
    }
    if (grid < 0) return;
    if (hipMemsetAsync((char*)d_ws + WS_CTL, 0, CTL_ZERO_BYTES, stream) != hipSuccess) return;
    Args a{};
    for (int i = 0; i < 17; ++i) a.in[i] = (const float*)d_in[i];
    a.out = (float*)d_out; a.ws = (unsigned char*)d_ws;
    hipLaunchKernelGGL(fwd_kernel, dim3(grid), dim3(NWAVES * 64), LDS_BYTES, stream, a);
}
```
